# Optimizing an MI355X kernel written in HIP

```python
import math
import jax
import jax.numpy as jnp
from jax import lax
import numpy as np

D_MODEL = 1024
BATCH = 8
SEQ = 8192
DEPTH = 1

GRID_W = 64
N_META = 16
NA_HEADS = 8
NA_HEAD_DIM = 64
NA_WIDTH = NA_HEADS * NA_HEAD_DIM
WIN_ROWS = 8
WIN_COLS = 16
DN_HEADS = 4
DN_KEY_DIM = 128
DN_VAL_DIM = 128
DN_QK_WIDTH = DN_HEADS * DN_KEY_DIM
DN_V_WIDTH = DN_HEADS * DN_VAL_DIM
CONV_W = 5
CHUNK = 64
MIX_WIDTH = NA_WIDTH + DN_V_WIDTH
D_FF = ((8 * D_MODEL + 3 * 256 - 1) // (3 * 256)) * 256
IN_SPLITS = (NA_WIDTH, NA_WIDTH, NA_WIDTH,
             DN_QK_WIDTH, DN_QK_WIDTH, DN_V_WIDTH, DN_V_WIDTH,
             2 * DN_HEADS, 2 * DN_HEADS)
IN_WIDTH = sum(IN_SPLITS)
EPS = 1e-6
NEG = -1e30

kernel_name = 'hybrid_natten_gated_deltanet_block'


def rmsnorm(x, g):
    x32 = x.astype(jnp.float32)
    y = x32 * lax.rsqrt(jnp.mean(x32 * x32, axis=-1, keepdims=True) + EPS)
    return (y * g.astype(jnp.float32)).astype(x.dtype)


def l2norm(x):
    x32 = x.astype(jnp.float32)
    return x32 * lax.rsqrt(jnp.sum(x32 * x32, axis=-1, keepdims=True) + EPS)


def split_points():
    pts, acc = [], 0
    for s in IN_SPLITS[:-1]:
        acc += s
        pts.append(acc)
    return pts


def neighbourhood_attention(q, k, v, rel_bias, rows):
    B, L, _ = q.shape
    H, dh = NA_HEADS, NA_HEAD_DIM
    kr, kc = min(WIN_ROWS, rows), WIN_COLS
    q = (q * (dh ** -0.5)).reshape(B, L, H, dh)
    k = k.reshape(B, L, H, dh)
    v = v.reshape(B, L, H, dh)
    qm, km, vm = q[:, :N_META], k[:, :N_META], v[:, :N_META]
    qg = q[:, N_META:].reshape(B, rows, GRID_W, H, dh)
    kg = k[:, N_META:].reshape(B, rows, GRID_W, H, dh)
    vg = v[:, N_META:].reshape(B, rows, GRID_W, H, dh)

    r = np.arange(rows)
    c = np.arange(GRID_W)
    key_rows = np.clip(r - kr // 2, 0, rows - kr)[:, None] + np.arange(kr)[None, :]
    col_start = np.clip(c - kc // 2, 0, GRID_W - kc)
    col_in = (c[None, :] >= col_start[:, None]) & (c[None, :] < col_start[:, None] + kc)
    dr_idx = key_rows - r[:, None] + (WIN_ROWS - 1)
    dc_idx = np.clip(c[None, :] - c[:, None], 1 - WIN_COLS, WIN_COLS - 1) + (WIN_COLS - 1)

    k_win = kg[:, key_rows]
    v_win = vg[:, key_rows].reshape(B, rows, kr * GRID_W, H, dh)

    bias = rel_bias.astype(jnp.float32)[:, dr_idx][:, :, :, dc_idx]
    bias = jnp.transpose(bias, (0, 1, 3, 2, 4))
    s_grid = jnp.einsum('brqhd,brikhd->bhrqik', qg, k_win).astype(jnp.float32) + bias
    s_grid = jnp.where(col_in[:, None, :], s_grid, NEG)
    s_meta = jnp.einsum('brqhd,bmhd->bhrqm', qg, km).astype(jnp.float32)
    logits = jnp.concatenate([s_grid.reshape(B, H, rows, GRID_W, kr * GRID_W), s_meta], axis=-1)
    p = jax.nn.softmax(logits, axis=-1).astype(v.dtype)
    o_grid = (jnp.einsum('bhrqn,brnhd->brqhd', p[..., :kr * GRID_W], v_win)
              + jnp.einsum('bhrqm,bmhd->brqhd', p[..., kr * GRID_W:], vm))
    o_grid = o_grid.reshape(B, rows * GRID_W, H * dh)

    pm = jax.nn.softmax(jnp.einsum('bmhd,bnhd->bhmn', qm, km).astype(jnp.float32), axis=-1).astype(v.dtype)
    o_meta = jnp.einsum('bhmn,bnhd->bmhd', pm, vm).reshape(B, N_META, H * dh)
    return jnp.concatenate([o_meta, o_grid], axis=1)


def short_conv(x, w):
    C = x.shape[-1]
    y = lax.conv_general_dilated(x, w[:, None, :].astype(x.dtype), window_strides=(1,),
                                 padding=[(CONV_W // 2, CONV_W // 2)],
                                 dimension_numbers=('NWC', 'WIO', 'NWC'),
                                 feature_group_count=C)
    return jax.nn.silu(y)


def to_chunks(x):
    B, T, H = x.shape[:3]
    x = x.reshape((B, T // CHUNK, CHUNK, H) + x.shape[3:])
    return jnp.moveaxis(x, 3, 1)


def chunked_gated_delta(q, k, v, g, beta):
    B, T, H, dk = q.shape
    dv = v.shape[-1]
    qc, kc_, vc = to_chunks(q), to_chunks(k), to_chunks(v)
    gc = jnp.cumsum(to_chunks(g), axis=-1)
    bc = to_chunks(beta)[..., None]
    kb = kc_ * bc
    vb = vc * bc
    incl = np.tril(np.ones((CHUNK, CHUNK), dtype=bool))
    strict = np.tril(np.ones((CHUNK, CHUNK), dtype=bool), -1)
    diff = gc[..., :, None] - gc[..., None, :]
    decay_mat = jnp.where(incl, jnp.exp(jnp.where(incl, diff, 0.0)), 0.0)
    m = jnp.where(strict, jnp.einsum('bhnid,bhnjd->bhnij', kb, kc_) * decay_mat, 0.0)
    a_mat = m + jnp.eye(CHUNK, dtype=jnp.float32)
    rhs = jnp.concatenate([vb, kb * jnp.exp(gc)[..., None]], axis=-1)
    sol = lax.linalg.triangular_solve(a_mat, rhs, left_side=True, lower=True, unit_diagonal=True)
    u = sol[..., :dv]
    w = sol[..., dv:]
    qk = jnp.einsum('bhnid,bhnjd->bhnij', qc, kc_) * decay_mat
    q_dec = qc * jnp.exp(gc)[..., None]
    k_dec = kc_ * jnp.exp(gc[..., -1:] - gc)[..., None]
    chunk_decay = jnp.exp(gc[..., -1])

    def step(state, xs):
        qk_i, q_i, w_i, u_i, k_i, cd_i = xs
        v_new = u_i - jnp.einsum('bhck,bhkv->bhcv', w_i, state)
        o_i = jnp.einsum('bhck,bhkv->bhcv', q_i, state) + jnp.einsum('bhij,bhjv->bhiv', qk_i, v_new)
        state = state * cd_i[..., None, None] + jnp.einsum('bhck,bhcv->bhkv', k_i, v_new)
        return state, o_i

    xs = tuple(jnp.moveaxis(t, 2, 0) for t in (qk, q_dec, w, u, k_dec, chunk_decay))
    s0 = jnp.zeros((B, H, dk, dv), jnp.float32)
    _, o = lax.scan(step, s0, xs)
    return jnp.transpose(o, (1, 0, 2, 3, 4)).transpose(0, 1, 3, 2, 4).reshape(B, T, H, dv)


def gated_deltanet(q, k, v, z, b, a, conv_w, a_log, dt_bias, norm_g):
    B, L, _ = q.shape
    H = DN_HEADS
    qkv = short_conv(jnp.concatenate([q, k, v], axis=-1), conv_w)
    q, k, v = jnp.split(qkv, [DN_QK_WIDTH, 2 * DN_QK_WIDTH], axis=-1)
    q = l2norm(q.reshape(B, L, H, DN_KEY_DIM)) * (DN_KEY_DIM ** -0.5)
    k = l2norm(k.reshape(B, L, H, DN_KEY_DIM))
    v = v.reshape(B, L, H, DN_VAL_DIM).astype(jnp.float32)
    beta = jax.nn.sigmoid(b.astype(jnp.float32)).reshape(B, L, 2, H)
    g = -jnp.exp(a_log.astype(jnp.float32)) * jax.nn.softplus(
        a.astype(jnp.float32).reshape(B, L, 2, H) + dt_bias.astype(jnp.float32))
    pad = (-L) % CHUNK

    def padf(t):
        return jnp.pad(t, [(0, 0), (pad, 0)] + [(0, 0)] * (t.ndim - 2))

    qp, kp, vp, gp, bp = padf(q), padf(k), padf(v), padf(g), padf(beta)
    o_fwd = chunked_gated_delta(qp, kp, vp, gp[:, :, 0], bp[:, :, 0])
    o_bwd = jnp.flip(chunked_gated_delta(jnp.flip(qp, 1), jnp.flip(kp, 1), jnp.flip(vp, 1),
                                         jnp.flip(gp[:, :, 1], 1), jnp.flip(bp[:, :, 1], 1)), 1)
    o = (o_fwd + o_bwd)[:, pad:]
    o = rmsnorm(o, norm_g) * jax.nn.silu(z.astype(jnp.float32).reshape(B, L, H, DN_VAL_DIM))
    return o.reshape(B, L, DN_V_WIDTH).astype(z.dtype)


def setup_inputs(seed: int = 0) -> dict:
    key = jax.random.key(seed)
    ks = jax.random.split(key, 16)
    f32 = jnp.float32

    def nrm(k, shape, scale):
        return jax.random.normal(k, shape, f32) * scale

    x = nrm(ks[0], (BATCH, SEQ, D_MODEL), 1.0)
    meta_tokens = nrm(ks[1], (N_META, D_MODEL), 1.0)
    g_mix = 1.0 + nrm(ks[2], (DEPTH, D_MODEL), 0.01)
    w_in = nrm(ks[3], (DEPTH, D_MODEL, IN_WIDTH), D_MODEL ** -0.5)
    na_rel_bias = nrm(ks[4], (DEPTH, NA_HEADS, 2 * WIN_ROWS - 1, 2 * WIN_COLS - 1), 0.02)
    dn_conv_w = nrm(ks[5], (DEPTH, CONV_W, 2 * DN_QK_WIDTH + DN_V_WIDTH), CONV_W ** -0.5)
    dn_a_log = jnp.log(jax.random.uniform(ks[6], (DEPTH, 2, DN_HEADS), f32, 1.0, 16.0))
    dt = jnp.exp(jax.random.uniform(ks[7], (DEPTH, 2, DN_HEADS), f32, math.log(1e-3), math.log(0.1)))
    dn_dt_bias = dt + jnp.log(-jnp.expm1(-dt))
    dn_norm_g = 1.0 + nrm(ks[8], (DEPTH, DN_VAL_DIM), 0.01)
    w_out = nrm(ks[9], (DEPTH, MIX_WIDTH, D_MODEL), MIX_WIDTH ** -0.5)
    g_ffn = 1.0 + nrm(ks[10], (DEPTH, D_MODEL), 0.01)
    w_gate = nrm(ks[11], (DEPTH, D_MODEL, D_FF), D_MODEL ** -0.5)
    w_up = nrm(ks[12], (DEPTH, D_MODEL, D_FF), D_MODEL ** -0.5)
    w_down = nrm(ks[13], (DEPTH, D_FF, D_MODEL), D_FF ** -0.5)
    g_final = 1.0 + nrm(ks[14], (D_MODEL,), 0.01)
    return {'x': x, 'meta_tokens': meta_tokens, 'g_mix': g_mix, 'w_in': w_in,
            'na_rel_bias': na_rel_bias, 'dn_conv_w': dn_conv_w, 'dn_a_log': dn_a_log,
            'dn_dt_bias': dn_dt_bias, 'dn_norm_g': dn_norm_g, 'w_out': w_out, 'g_ffn': g_ffn,
            'w_gate': w_gate, 'w_up': w_up, 'w_down': w_down, 'g_final': g_final}


def reference(x, meta_tokens, g_mix, w_in, na_rel_bias, dn_conv_w, dn_a_log, dn_dt_bias,
              dn_norm_g, w_out, g_ffn, w_gate, w_up, w_down, g_final):
    B, S, D = x.shape
    rows = S // GRID_W
    meta = jnp.broadcast_to(meta_tokens[None].astype(x.dtype), (B, N_META, D))
    h = jnp.concatenate([meta, x], axis=1)
    pts = split_points()
    for l in range(DEPTH):
        u = rmsnorm(h, g_mix[l])
        proj = u @ w_in[l]
        na_q, na_k, na_v, dn_q, dn_k, dn_v, dn_z, dn_b, dn_a = jnp.split(proj, pts, axis=-1)
        y_na = neighbourhood_attention(na_q, na_k, na_v, na_rel_bias[l], rows)
        y_dn = gated_deltanet(dn_q, dn_k, dn_v, dn_z, dn_b, dn_a, dn_conv_w[l], dn_a_log[l],
                              dn_dt_bias[l], dn_norm_g[l])
        h = h + jnp.concatenate([y_na, y_dn], axis=-1) @ w_out[l]
        u = rmsnorm(h, g_ffn[l])
        h = h + (jax.nn.silu(u @ w_gate[l]) * (u @ w_up[l])) @ w_down[l]
    return rmsnorm(h, g_final)[:, N_META:]
```

```cpp
#include <hip/hip_runtime.h>
#include <hip/hip_bf16.h>
#include <hip/hip_cooperative_groups.h>
#include <cstdio>
namespace cg = cooperative_groups;

typedef unsigned short u16;
using bf16x8 = __attribute__((ext_vector_type(8))) short;
using s16x4 = __attribute__((ext_vector_type(4))) short;
using f32x4 = __attribute__((ext_vector_type(4))) float;

constexpr int DM = 1024, NB = 8, SEQ = 8192, NMETA = 16, LL = SEQ + NMETA, MT = NB * LL;
constexpr int INW = 3600, INP = 3840, PW = 3136;
constexpr int MC = NB * SEQ;
constexpr int DFF = 2816;
constexpr int NCH = 129;
constexpr int NTHR = 512;
constexpr int HLDS = 77824;
constexpr int LDS_BYTES = 2 * HLDS;
constexpr float EPSF = 1e-6f;

constexpr int PC_NAQ = 0, PC_Z = 512, PC_NAK = 1024, PC_DNQ = 1536, PC_DNK = 2048, PC_DNV = 2560, PC_B = 3072, PC_A = 3080;

struct Params {
  const float *x, *meta, *g_mix, *w_in, *rel_bias, *conv_w, *a_log, *dt_bias, *norm_g, *w_out, *g_ffn, *w_gate, *w_up, *w_down, *g_final;
  float* out;
  u16 *WinT, *WoutT, *WguT, *WdT;
  float *rs1, *ss2, *ss3;
  u16* hb;
  u16* proj;
  u16* Vt;
  u16 *qn, *knT, *uT, *wS, *qkS;
  float *egS, *ekS, *cdS;
  float* h1;
  u16* h2b;
  u16* h1b;
  u16* act;
  unsigned* bar;
  int phase_lo, phase_hi;
};

__device__ __forceinline__ float bf2f(u16 h) { return __uint_as_float(((unsigned)h) << 16); }
typedef __bf16 bf16x2_t __attribute__((ext_vector_type(2)));
typedef float f32x2_t __attribute__((ext_vector_type(2)));
__device__ __forceinline__ unsigned pack2(float a, float b) { f32x2_t v = {a, b}; bf16x2_t r = __builtin_convertvector(v, bf16x2_t); return __builtin_bit_cast(unsigned, r); }
__device__ __forceinline__ u16 f2bf(float f) { return (u16)(pack2(f, 0.f) & 0xffffu); }
__device__ __forceinline__ uint2 pack4(f32x4 v) { return make_uint2(pack2(v[0], v[1]), pack2(v[2], v[3])); }
__device__ __forceinline__ bf16x8 pack8(f32x4 a, f32x4 b) {
  union { bf16x8 v; unsigned u[4]; } r;
  r.u[0] = pack2(a[0], a[1]); r.u[1] = pack2(a[2], a[3]); r.u[2] = pack2(b[0], b[1]); r.u[3] = pack2(b[2], b[3]);
  return r.v;
}
__device__ __forceinline__ bf16x8 ld8(const u16* p) { return *reinterpret_cast<const bf16x8*>(p); }
__device__ __forceinline__ bf16x8 ld4x2(const u16* p0, const u16* p1) {
  union { bf16x8 v; uint2 u[2]; } r;
  r.u[0] = *reinterpret_cast<const uint2*>(p0);
  r.u[1] = *reinterpret_cast<const uint2*>(p1);
  return r.v;
}
__device__ __forceinline__ f32x4 mfma16(bf16x8 a, bf16x8 b, f32x4 c) { return __builtin_amdgcn_mfma_f32_16x16x32_bf16(a, b, c, 0, 0, 0); }
__device__ __forceinline__ int sigma(int c) { return (c & ~31) | (((c >> 2) & 3) << 3) | (((c >> 4) & 1) << 2) | (c & 3); }

__device__ void wprep_tile(const Params& p, int item, char* smem, const int tid) {
  float* tl = (float*)smem;
  int type, tr, tk;
  if (item < 960) { type = 0; tr = item / 16; tk = item % 16; }
  else if (item < 1216) { item -= 960; type = 1; tr = item / 16; tk = item % 16; }
  else if (item < 2624) { item -= 1216; type = 2; tr = item / 16; tk = item % 16; }
  else { item -= 2624; type = 3; tr = item / 44; tk = item % 44; }
  int r0 = tr * 64 + (tid & 15) * 4;
  const float* src; int sstride; bool valid = true; const float* gain = nullptr; u16* dst; int kd = 1024;
  if (type == 0) { src = p.w_in + r0; sstride = INW; valid = r0 < INW; gain = p.g_mix; dst = p.WinT; }
  else if (type == 1) { src = p.w_out + r0; sstride = 1024; dst = p.WoutT; }
  else if (type == 2) { int grp = r0 >> 8, wi = r0 & 255; int ff = grp * 128 + (wi & 127); src = (wi < 128 ? p.w_gate : p.w_up) + ff; sstride = DFF; gain = p.g_ffn; dst = p.WguT; }
  else { src = p.w_down + r0; sstride = 1024; dst = p.WdT; kd = DFF; }
  __syncthreads();
#pragma unroll
  for (int i = 0; i < 4; ++i) {
    int kk = (tid >> 4) + 16 * i;
    int k = tk * 64 + kk;
    float4 v = make_float4(0.f, 0.f, 0.f, 0.f);
    if (valid) v = *reinterpret_cast<const float4*>(src + (size_t)k * sstride);
    float g = gain ? gain[k] : 1.f;
    int nn = (tid & 15) * 4;
    tl[(nn + 0) * 65 + kk] = v.x * g; tl[(nn + 1) * 65 + kk] = v.y * g; tl[(nn + 2) * 65 + kk] = v.z * g; tl[(nn + 3) * 65 + kk] = v.w * g;
  }
  __syncthreads();
  int n = tid >> 2, ks = (tid & 3) * 16;
  unsigned o[8];
#pragma unroll
  for (int e = 0; e < 8; ++e) o[e] = pack2(tl[n * 65 + ks + 2 * e], tl[n * 65 + ks + 2 * e + 1]);
  u16* d = dst + (size_t)(tr * 64 + n) * kd + tk * 64 + ks;
  *reinterpret_cast<uint4*>(d) = make_uint4(o[0], o[1], o[2], o[3]);
  *reinterpret_cast<uint4*>(d + 8) = make_uint4(o[4], o[5], o[6], o[7]);
}

__device__ void phase0(const Params& p, char* smem) {
  const int NW = 3328;
  const int half = threadIdx.x >> 8, tid = threadIdx.x & 255;
  for (int it = blockIdx.x * 2 + half; it < NW; it += gridDim.x * 2) wprep_tile(p, it, smem + half * HLDS, tid);
  int lane = threadIdx.x & 63, wv = threadIdx.x >> 6;
  for (int row0 = (blockIdx.x * 8 + wv) * 2; row0 < MC + NMETA; row0 += gridDim.x * 16) {
    float4 v[2][4];
#pragma unroll
    for (int r = 0; r < 2; ++r) {
      const int row = row0 + r;
      const float* src = (row < MC) ? (p.x + (size_t)row * DM) : (p.meta + (size_t)(row - MC) * DM);
#pragma unroll
      for (int i = 0; i < 4; ++i) v[r][i] = *reinterpret_cast<const float4*>(src + i * 256 + lane * 4);
    }
#pragma unroll
    for (int r = 0; r < 2; ++r) {
      const int row = row0 + r;
      float ss = 0.f;
#pragma unroll
      for (int i = 0; i < 4; ++i) {
        const float4 w = v[r][i];
        ss += w.x * w.x + w.y * w.y + w.z * w.z + w.w * w.w;
      }
#pragma unroll
      for (int o = 32; o >= 1; o >>= 1) ss += __shfl_xor(ss, o);
      const float rs = rsqrtf(ss * (1.f / DM) + EPSF);
#pragma unroll
      for (int i = 0; i < 4; ++i) {
        const float4 w = v[r][i];
        *reinterpret_cast<uint2*>(p.hb + (size_t)row * DM + i * 256 + lane * 4) = make_uint2(pack2(w.x * rs, w.y * rs), pack2(w.z * rs, w.w * rs));
      }
      if (lane == 0 && row < MC) { p.ss2[row] = 0.f; p.ss3[row] = 0.f; }
    }
  }
}

#define LAS __attribute__((address_space(3)))
constexpr int BM = 256, BK = 64, HALF = 128, HTB = HALF * BK * 2, STAGE_BYTES = 8 * HTB, NXCD = 8, WGM = 8;
__device__ __forceinline__ int lds_byte(int r, int c) { const int st = (r >> 4) * 2 + (c >> 5), rr = r & 15, cc = c & 31, ob = rr * 64 + cc * 2; return st * 1024 + (ob ^ (((ob >> 9) & 1) << 5)); }
__device__ __forceinline__ void stage_rc(int b, int& R, int& C) { const int st = b / 1024, sb = b % 1024, swz = sb ^ (((sb >> 9) & 1) << 5); R = (st >> 1) * 16 + swz / 64; C = (st & 1) * 32 + (swz % 64) / 2; }
__device__ __forceinline__ int perm32(int rho) { const int n = rho >> 4, i = rho & 15; return 8 * (i >> 2) + 4 * n + (i & 3); }
struct Unit { int pm, pn; };
struct StaticOrder {
  int nM, nN, nwg, G, c;
  __device__ void init(int nM_, int nN_, int G_, int c_) { nM = nM_; nN = nN_; nwg = nM * nN; G = G_; c = c_; }
  __device__ bool next(int i, Unit& u) const {
    const long L = (long)i * G + c; if (L >= nwg) return false;
    int wgid = (int)L; { const int q = nwg / NXCD, r = nwg % NXCD, xcd = wgid % NXCD, off = wgid / NXCD; wgid = (xcd < r ? xcd * (q + 1) : r * (q + 1) + (xcd - r) * q) + off; }
    const int nig = WGM * nN, gid = wgid / nig, fm = gid * WGM, gsz = (nM - fm) < WGM ? (nM - fm) : WGM;
    u.pm = fm + ((wgid % nig) % gsz); u.pn = (wgid % nig) / gsz; return true;
  }
};

__device__ __forceinline__ int proj_col(int c) {
  if (c < 512) return PC_NAQ + c;
  if (c < 1024) return PC_NAK + (c - 512);
  if (c < 1536) return -1;
  if (c < 2048) return PC_DNQ + (c - 1536);
  if (c < 2560) return PC_DNK + (c - 2048);
  if (c < 3072) return PC_DNV + (c - 2560);
  if (c < 3584) return PC_Z + (c - 3072);
  if (c < 3592) return PC_B + (c - 3584);
  if (c < 3600) return PC_A + (c - 3592);
  return -2;
}

template <int EPI>
__device__ __forceinline__ void gemm_epi(const Params& p, const f32x4 (&acc)[2][2][4][2], const Unit& u, int wr, int wc, int fr, int fq) {
  const int mc0 = u.pm * BM + wr * 64 + fr;
  if constexpr (EPI == 1 || EPI == 4) {
    float rsv[2][4];
#pragma unroll
    for (int ai = 0; ai < 2; ++ai)
#pragma unroll
      for (int m = 0; m < 4; ++m) {
        const int mc = mc0 + ai * HALF + m * 16;
        rsv[ai][m] = (EPI == 1) ? 1.f : p.ss2[mc];
      }
#pragma unroll
    for (int ai = 0; ai < 2; ++ai)
#pragma unroll
      for (int m = 0; m < 4; ++m) {
        const int mc = mc0 + ai * HALF + m * 16;
        if constexpr (EPI == 1) {
          const int b = mc >> 13, t = NMETA + (mc & 8191);
          const size_t mf = (size_t)b * LL + t;
#pragma unroll
          for (int bj = 0; bj < 2; ++bj) {
            const int c8 = u.pn * BM + bj * HALF + wc * 32 + fq * 8;
            const int col = proj_col(c8);
            f32x4 v0 = acc[ai][bj][m][0], v1 = acc[ai][bj][m][1];
            if (c8 < 512) { v0 = v0 * 0.125f; v1 = v1 * 0.125f; }
            if (col >= 0) {
              *reinterpret_cast<uint4*>(p.proj + mf * PW + col) = make_uint4(pack2(v0[0], v0[1]), pack2(v0[2], v0[3]), pack2(v1[0], v1[1]), pack2(v1[2], v1[3]));
            } else if (col == -1) {
              u16* vp = p.Vt + ((size_t)(b * 512 + c8 - 1024)) * LL + t;
#pragma unroll
              for (int j = 0; j < 4; ++j) { vp[(size_t)j * LL] = f2bf(v0[j]); vp[(size_t)(4 + j) * LL] = f2bf(v1[j]); }
            }
          }
        } else {
          const float r2 = rsqrtf(rsv[ai][m] * (1.f / DM) + EPSF);
          const int ff8 = u.pn * HALF + wc * 32 + fq * 8;
          float a[8];
#pragma unroll
          for (int n = 0; n < 2; ++n)
#pragma unroll
            for (int j = 0; j < 4; ++j) {
              const float g = acc[ai][0][m][n][j] * r2, uu = acc[ai][1][m][n][j] * r2;
              a[n * 4 + j] = g * __builtin_amdgcn_rcpf(1.f + __expf(-g)) * uu;
            }
          *reinterpret_cast<uint4*>(p.act + (size_t)mc * DFF + ff8) = make_uint4(pack2(a[0], a[1]), pack2(a[2], a[3]), pack2(a[4], a[5]), pack2(a[6], a[7]));
        }
      }
  } else {
    const int c80 = u.pn * BM + wc * 32 + fq * 8;
#pragma unroll
    for (int ai = 0; ai < 2; ++ai) {
      float4 rx[4][2][2];
      uint4 rh[4][2];
#pragma unroll
      for (int m = 0; m < 4; ++m) {
        const int mc = mc0 + ai * HALF + m * 16;
#pragma unroll
        for (int bj = 0; bj < 2; ++bj) {
          if constexpr (EPI == 3) {
            const float* res = p.x + (size_t)mc * DM + c80 + bj * HALF;
            rx[m][bj][0] = *reinterpret_cast<const float4*>(res); rx[m][bj][1] = *reinterpret_cast<const float4*>(res + 4);
          } else {
            rh[m][bj] = *reinterpret_cast<const uint4*>(p.h1b + (size_t)mc * DM + c80 + bj * HALF);
          }
        }
      }
#pragma unroll
      for (int m = 0; m < 4; ++m) {
        const int mc = mc0 + ai * HALF + m * 16;
        float ss = 0.f;
#pragma unroll
        for (int bj = 0; bj < 2; ++bj) {
          const int c8 = c80 + bj * HALF;
          f32x4 v0 = acc[ai][bj][m][0], v1 = acc[ai][bj][m][1];
          if constexpr (EPI == 3) {
            const float4 r0 = rx[m][bj][0], r1 = rx[m][bj][1];
            v0[0] += r0.x; v0[1] += r0.y; v0[2] += r0.z; v0[3] += r0.w;
            v1[0] += r1.x; v1[1] += r1.y; v1[2] += r1.z; v1[3] += r1.w;
            *reinterpret_cast<uint4*>(p.h1b + (size_t)mc * DM + c8) = make_uint4(pack2(v0[0], v0[1]), pack2(v0[2], v0[3]), pack2(v1[0], v1[1]), pack2(v1[2], v1[3]));
          } else {
            const uint4 rb = rh[m][bj];
            v0[0] += __uint_as_float(rb.x << 16); v0[1] += __uint_as_float(rb.x & 0xffff0000u);
            v0[2] += __uint_as_float(rb.y << 16); v0[3] += __uint_as_float(rb.y & 0xffff0000u);
            v1[0] += __uint_as_float(rb.z << 16); v1[1] += __uint_as_float(rb.z & 0xffff0000u);
            v1[2] += __uint_as_float(rb.w << 16); v1[3] += __uint_as_float(rb.w & 0xffff0000u);
            *reinterpret_cast<uint4*>(p.h2b + (size_t)mc * DM + c8) = make_uint4(pack2(v0[0], v0[1]), pack2(v0[2], v0[3]), pack2(v1[0], v1[1]), pack2(v1[2], v1[3]));
          }
#pragma unroll
          for (int j = 0; j < 4; ++j) ss += v0[j] * v0[j] + v1[j] * v1[j];
        }
        ss += __shfl_xor(ss, 16); ss += __shfl_xor(ss, 32);
        if (fq == 0) atomicAdd(((EPI == 3) ? p.ss2 : p.ss3) + mc, ss);
      }
    }
  }
}

template <int EPI, bool ROWMAP>
__device__ __forceinline__ void gemm_phase(const Params& p, LAS unsigned char* lds, const u16* A, const int lda, const u16* Bt, const int nN, const int K) {
  const int tid = threadIdx.x, wid = __builtin_amdgcn_readfirstlane(tid >> 6), lane = tid & 63, wr = wid >> 2, wc = wid & 3, fr = lane & 15, fq = lane >> 4;
  const int nt = K / BK;
  StaticOrder S; S.init(MC / BM, nN, gridDim.x, blockIdx.x);
  unsigned voffA[2], voffB[2];
#pragma unroll
  for (int i = 0; i < 2; ++i) { int R, C; stage_rc(tid * 16 + i * 8192, R, C); const int Rb = (R & ~31) + perm32(R & 31);
    voffA[i] = (unsigned)(R * lda + C) * 2u; voffB[i] = (unsigned)(Rb * K + C) * 2u; }
  const size_t kstep = (size_t)(BK * 2);
  const size_t hstepA = (size_t)HALF * lda * 2, hstepB = (size_t)HALF * K * 2;
  const unsigned ldsw = (unsigned)wid * 1024u;
  const int aoff = lds_byte(wr * 64 + fr, fq * 8), boff = lds_byte(wc * 32 + fr, fq * 8);
#define PG8_ABASE(pm_) ((const char*)A + (size_t)(ROWMAP ? (((pm_) >> 5) * LL + NMETA + ((pm_) & 31) * BM) : (pm_) * BM) * lda * 2)
#define PG8_BBASE(pn_) ((const char*)Bt + (size_t)(pn_) * 2 * hstepB)
#define PG8_SA(b, h) (((b) * 2 + (h)) * HTB)
#define PG8_SB(b, h) ((4 + (b) * 2 + (h)) * HTB)
#define PG8_STAGE(bufoff, gbase, voff) do { _Pragma("unroll") for (int _i = 0; _i < 2; ++_i) \
    __builtin_amdgcn_global_load_lds((const unsigned*)((const char*)(gbase) + (voff)[_i]), (LAS unsigned*)(lds + (bufoff) + ldsw + _i * 8192), 16, 0, 0); } while (0)
#define PG8_LDA(dst, b, h) do { _Pragma("unroll") for (int m = 0; m < 4; ++m) _Pragma("unroll") for (int k = 0; k < 2; ++k) dst[m][k] = *(const LAS bf16x8*)(lds + PG8_SA(b, h) + aoff + m * 2048 + k * 1024); } while (0)
#define PG8_LDB(dst, b, h) do { _Pragma("unroll") for (int n = 0; n < 2; ++n) _Pragma("unroll") for (int k = 0; k < 2; ++k) dst[n][k] = *(const LAS bf16x8*)(lds + PG8_SB(b, h) + boff + n * 2048 + k * 1024); } while (0)
#define PG8_MMA(ai, bj, At, Bt_) do { __builtin_amdgcn_s_setprio(1); _Pragma("unroll") for (int m = 0; m < 4; ++m) _Pragma("unroll") for (int n = 0; n < 2; ++n) _Pragma("unroll") for (int k = 0; k < 2; ++k) \
    acc[ai][bj][m][n] = __builtin_amdgcn_mfma_f32_16x16x32_bf16(Bt_[n][k], At[m][k], acc[ai][bj][m][n], 0, 0, 0); __builtin_amdgcn_s_setprio(0); } while (0)
#define PG8_WAIT_V(n) asm volatile("s_waitcnt vmcnt(" #n ")" ::: "memory")
#define PG8_WAIT_L(n) asm volatile("s_waitcnt lgkmcnt(" #n ")" ::: "memory")
#define PG8_BAR __builtin_amdgcn_s_barrier()
#define PG8_SCHED __builtin_amdgcn_sched_barrier(0)
  Unit cur, nxt; int ui = 0;
  if (!S.next(0, cur)) return;
  f32x4 acc[2][2][4][2];
#pragma unroll
  for (int a = 0; a < 2; ++a)
#pragma unroll
    for (int b = 0; b < 2; ++b)
#pragma unroll
      for (int m = 0; m < 4; ++m)
#pragma unroll
        for (int n = 0; n < 2; ++n) acc[a][b][m][n] = f32x4{0.f, 0.f, 0.f, 0.f};
  bf16x8 At[4][2], B0[2][2], B1[2][2];
  const char* cA = PG8_ABASE(cur.pm); const char* cB = PG8_BBASE(cur.pn);
  PG8_STAGE(PG8_SB(0, 0), cB, voffB); PG8_STAGE(PG8_SA(0, 0), cA, voffA); PG8_STAGE(PG8_SB(0, 1), cB + hstepB, voffB); PG8_STAGE(PG8_SA(0, 1), cA + hstepA, voffA);
  if (wr == 1) PG8_BAR;
  PG8_WAIT_V(4); PG8_BAR;
  PG8_STAGE(PG8_SB(1, 0), cB + kstep, voffB); PG8_STAGE(PG8_SA(1, 0), cA + kstep, voffA); PG8_STAGE(PG8_SB(1, 1), cB + hstepB + kstep, voffB);
  PG8_WAIT_V(6); PG8_BAR;
  for (;;) {
    const bool has_next = S.next(ui + 1, nxt);
    const char* nA = has_next ? PG8_ABASE(nxt.pm) : cA; const char* nB = has_next ? PG8_BBASE(nxt.pn) : cB;
    for (int t = 0; t < nt; t += 2) {
      const bool last = (t == nt - 2);
      const char* a1 = cA + (size_t)(t + 1) * kstep;
      const char* a2 = last ? nA : cA + (size_t)(t + 2) * kstep; const char* b2 = last ? nB : cB + (size_t)(t + 2) * kstep;
      const char* a3 = a2 + kstep; const char* b3 = b2 + kstep;
      PG8_LDB(B0, 0, 0); PG8_SCHED; PG8_LDA(At, 0, 0); PG8_STAGE(PG8_SA(1, 1), a1 + hstepA, voffA);
      PG8_WAIT_L(8); PG8_BAR; PG8_WAIT_L(0); PG8_MMA(0, 0, At, B0); PG8_BAR; PG8_SCHED;
      PG8_LDB(B1, 0, 1); PG8_STAGE(PG8_SB(0, 0), b2, voffB);
      PG8_BAR; PG8_WAIT_L(0); PG8_MMA(0, 1, At, B1); PG8_BAR;
      PG8_LDA(At, 0, 1); PG8_STAGE(PG8_SA(0, 0), a2, voffA);
      PG8_BAR; PG8_WAIT_L(0); PG8_MMA(1, 0, At, B0); PG8_BAR; PG8_SCHED;
      PG8_STAGE(PG8_SB(0, 1), b2 + hstepB, voffB);
      PG8_WAIT_V(6); PG8_BAR; PG8_MMA(1, 1, At, B1); PG8_BAR;
      PG8_LDB(B0, 1, 0); PG8_SCHED; PG8_LDA(At, 1, 0); PG8_STAGE(PG8_SA(0, 1), a2 + hstepA, voffA);
      PG8_WAIT_L(8); PG8_BAR; PG8_WAIT_L(0); PG8_MMA(0, 0, At, B0); PG8_BAR; PG8_SCHED;
      PG8_LDB(B1, 1, 1); PG8_STAGE(PG8_SB(1, 0), b3, voffB);
      PG8_BAR; PG8_WAIT_L(0); PG8_MMA(0, 1, At, B1); PG8_BAR;
      PG8_LDA(At, 1, 1); PG8_STAGE(PG8_SA(1, 0), a3, voffA);
      PG8_BAR; PG8_WAIT_L(0); PG8_MMA(1, 0, At, B0); PG8_BAR; PG8_SCHED;
      PG8_STAGE(PG8_SB(1, 1), b3 + hstepB, voffB);
      PG8_WAIT_V(6); PG8_BAR; PG8_MMA(1, 1, At, B1); PG8_BAR;
    }
    gemm_epi<EPI>(p, acc, cur, wr, wc, fr, fq);
    if (!has_next) break;
#pragma unroll
    for (int a = 0; a < 2; ++a)
#pragma unroll
      for (int b = 0; b < 2; ++b)
#pragma unroll
        for (int m = 0; m < 4; ++m)
#pragma unroll
          for (int n = 0; n < 2; ++n) acc[a][b][m][n] = f32x4{0.f, 0.f, 0.f, 0.f};
    cur = nxt; cA = nA; cB = nB; ++ui;
  }
  PG8_WAIT_V(0);
  if (wr == 0) PG8_BAR;
  PG8_BAR;
#undef PG8_ABASE
#undef PG8_BBASE
#undef PG8_SA
#undef PG8_SB
#undef PG8_STAGE
#undef PG8_LDA
#undef PG8_LDB
#undef PG8_MMA
}

__device__ void meta_inproj(const Params& p) {
  const int lane = threadIdx.x & 63, l16 = lane & 15, quad = lane >> 4;
  for (int nt = blockIdx.x * 8 + (threadIdx.x >> 6); nt < INW / 16; nt += gridDim.x * 8) {
    f32x4 acc = f32x4{0.f, 0.f, 0.f, 0.f};
    const u16* wrow = p.WinT + (size_t)(nt * 16 + l16) * DM + quad * 8;
    const u16* arow = p.hb + (size_t)(MC + l16) * DM + quad * 8;
#pragma unroll 4
    for (int ks = 0; ks < 32; ++ks) acc = mfma16(ld8(wrow + ks * 32), ld8(arow + ks * 32), acc);
    const int c = nt * 16 + quad * 4;
    f32x4 v = acc;
    if (c < 512) v = v * 0.125f;
    const int col = proj_col(c);
    for (int b = 0; b < NB; ++b) {
      if (col >= 0) *reinterpret_cast<uint2*>(p.proj + ((size_t)b * LL + l16) * PW + col) = pack4(v);
      else if (col == -1) {
#pragma unroll
        for (int j = 0; j < 4; ++j) p.Vt[((size_t)(b * 512 + c - 1024 + j)) * LL + l16] = f2bf(v[j]);
      }
    }
  }
}

template <int NG>
__device__ __forceinline__ void na_wave(const Params& p, int b, int h, int qtok0, int r, int wq, int kr0, int jb0) {
  const int lane = threadIdx.x & 63, l16 = lane & 15, quad = lane >> 4;
  u16* proj = p.proj + (size_t)b * LL * PW;
  const u16* Vt = p.Vt + (size_t)(b * 512 + h * 64) * LL;
  const int qtok = qtok0 + l16;
  bf16x8 qf0 = ld8(proj + (size_t)qtok * PW + PC_NAQ + h * 64 + quad * 8);
  bf16x8 qf1 = ld8(proj + (size_t)qtok * PW + PC_NAQ + h * 64 + 32 + quad * 8);
  constexpr int NTL = NG + 1;
  f32x4 sc[NTL];
  const int qc = wq * 16 + l16;
  const int cs = min(max(qc - 8, 0), 48);
  const float* bias_h = p.rel_bias + h * (15 * 31);
#pragma unroll
  for (int t = 0; t < NG; ++t) {
    const int i = t / 3, jj = t % 3;
    const int ktok = NMETA + (kr0 + i) * 64 + (jb0 + jj) * 16 + l16;
    const u16* kp = proj + (size_t)ktok * PW + PC_NAK + h * 64 + quad * 8;
    f32x4 a = f32x4{0.f, 0.f, 0.f, 0.f};
    a = mfma16(ld8(kp), qf0, a);
    a = mfma16(ld8(kp + 32), qf1, a);
    const float* brow = bias_h + (kr0 + i - r + 7) * 31;
#pragma unroll
    for (int j = 0; j < 4; ++j) {
      const int kc = (jb0 + jj) * 16 + quad * 4 + j;
      const int dc = min(max(kc - qc, -15), 15) + 15;
      const bool in = (kc >= cs) && (kc < cs + 16);
      a[j] = in ? (a[j] + brow[dc]) : -1e30f;
    }
    sc[t] = a;
    if (t % 3 == 2) asm volatile("" ::: "memory");
  }
  {
    const u16* kp = proj + (size_t)l16 * PW + PC_NAK + h * 64 + quad * 8;
    f32x4 a = f32x4{0.f, 0.f, 0.f, 0.f};
    a = mfma16(ld8(kp), qf0, a);
    a = mfma16(ld8(kp + 32), qf1, a);
    sc[NG] = a;
  }
  float mx = -1e30f;
#pragma unroll
  for (int t = 0; t < NTL; ++t)
#pragma unroll
    for (int j = 0; j < 4; ++j) mx = fmaxf(mx, sc[t][j]);
  mx = fmaxf(mx, __shfl_xor(mx, 16));
  mx = fmaxf(mx, __shfl_xor(mx, 32));
  float sum = 0.f;
#pragma unroll
  for (int t = 0; t < NTL; ++t)
#pragma unroll
    for (int j = 0; j < 4; ++j) { float e = __expf(sc[t][j] - mx); sc[t][j] = e; sum += e; }
  sum += __shfl_xor(sum, 16);
  sum += __shfl_xor(sum, 32);
  const float inv = 1.f / sum;
  f32x4 o[4];
#pragma unroll
  for (int d = 0; d < 4; ++d) o[d] = f32x4{0.f, 0.f, 0.f, 0.f};
#pragma unroll
  for (int pr = 0; pr < NG / 2; ++pr) {
    const int t0 = 2 * pr, t1 = 2 * pr + 1;
    const int tok0 = NMETA + (kr0 + t0 / 3) * 64 + (jb0 + t0 % 3) * 16 + quad * 4;
    const int tok1 = NMETA + (kr0 + t1 / 3) * 64 + (jb0 + t1 % 3) * 16 + quad * 4;
    bf16x8 pf = pack8(sc[t0], sc[t1]);
#pragma unroll
    for (int d = 0; d < 4; ++d) {
      const u16* vr = Vt + (size_t)(d * 16 + l16) * LL;
      o[d] = mfma16(ld4x2(vr + tok0, vr + tok1), pf, o[d]);
    }
    if (pr & 1) asm volatile("" ::: "memory");
  }
  {
    f32x4 z = f32x4{0.f, 0.f, 0.f, 0.f};
    bf16x8 pf = pack8(sc[NG], z);
#pragma unroll
    for (int d = 0; d < 4; ++d) {
      const u16* vr = Vt + (size_t)(d * 16 + l16) * LL;
      union { bf16x8 v; uint2 u[2]; } vf;
      vf.u[0] = *reinterpret_cast<const uint2*>(vr + quad * 4);
      vf.u[1] = make_uint2(0u, 0u);
      o[d] = mfma16(vf.v, pf, o[d]);
    }
  }
#pragma unroll
  for (int d = 0; d < 4; ++d) {
    f32x4 v = o[d] * inv;
    *reinterpret_cast<uint2*>(proj + (size_t)qtok * PW + PC_NAQ + h * 64 + d * 16 + quad * 4) = pack4(v);
  }
}

__device__ void na_item(const Params& p, int item) {
  const int wv = (threadIdx.x >> 6) & 3;
  if (item < 8192) {
    const int h = item & 7, r = (item >> 3) & 127, b = item >> 10;
    const int kr0 = min(max(r - 4, 0), 120);
    const int jb0 = min(max(wv - 1, 0), 1);
    na_wave<24>(p, b, h, NMETA + r * 64 + wv * 16, r, wv, kr0, jb0);
  } else {
    item -= 8192;
    if (wv == 0) na_wave<0>(p, item >> 3, item & 7, 0, 0, 0, 0, 0);
  }
}

__device__ __forceinline__ f32x4 na_tile(const int t, const u16* KL, const int jb0, const int l16, const int quad, const bf16x8 qf0, const bf16x8 qf1,
                                         const float* bias_h, const int dr0, const int qc, const int cs) {
  const int i = t / 3, jj = t % 3;
  const u16* kp = KL + (i * 64 + (jb0 + jj) * 16 + l16) * 72 + quad * 8;
  f32x4 a = f32x4{0.f, 0.f, 0.f, 0.f};
  a = mfma16(ld8(kp), qf0, a);
  a = mfma16(ld8(kp + 32), qf1, a);
  const float* brow = bias_h + (dr0 + i) * 31;
#pragma unroll
  for (int j = 0; j < 4; ++j) {
    const int kc = (jb0 + jj) * 16 + quad * 4 + j;
    const int dc = min(max(kc - qc, -15), 15) + 15;
    const bool in = (kc >= cs) && (kc < cs + 16);
    a[j] = in ? (a[j] + brow[dc]) : -1e30f;
  }
  return a;
}
constexpr int NA_VS = 536;
__device__ void na_items(const Params& p, char* hsm, const int tid_in, const int first_item, const int stride) {
  int tid = tid_in;
  asm volatile("" : "+v"(tid));
  const int lane = tid & 63, wv = tid >> 6, l16 = lane & 15, quad = lane >> 4;
  u16* KL = (u16*)hsm;
  u16* VT = (u16*)hsm;
  uint4 k0, k1, k2, k3, k4, k5, k6, k7, k8, k9, k10, k11, k12, k13, k14, k15, km;
  bf16x8 qf0, qf1;
  float kbias;
  const int jb0 = min(max(wv - 1, 0), 1);
  const int qc = wv * 16 + l16;
  const int cs = min(max(qc - 8, 0), 48);
  float* BL = (float*)(hsm + 76032);
  const int brow_ = min(tid / 31, 7), bcol_ = tid % 31;
#define NA_KLOAD(item_)                                                                                              \
  {                                                                                                                  \
    const int h_ = (item_) & 7, r_ = ((item_) >> 3) & 127, b_ = (item_) >> 10;                                        \
    const int kr0_ = min(max(r_ - 4, 0), 120);                                                                       \
    const u16* pb_ = p.proj + (size_t)b_ * LL * PW;                                                                  \
    const u16* kp_ = pb_ + (size_t)(NMETA + kr0_ * 64 + (tid >> 3)) * PW + PC_NAK + h_ * 64 + (tid & 7) * 8;         \
    k0 = *reinterpret_cast<const uint4*>(kp_); k1 = *reinterpret_cast<const uint4*>(kp_ + (size_t)32 * PW);         \
    k2 = *reinterpret_cast<const uint4*>(kp_ + (size_t)64 * PW); k3 = *reinterpret_cast<const uint4*>(kp_ + (size_t)96 * PW);   \
    k4 = *reinterpret_cast<const uint4*>(kp_ + (size_t)128 * PW); k5 = *reinterpret_cast<const uint4*>(kp_ + (size_t)160 * PW); \
    k6 = *reinterpret_cast<const uint4*>(kp_ + (size_t)192 * PW); k7 = *reinterpret_cast<const uint4*>(kp_ + (size_t)224 * PW); \
    k8 = *reinterpret_cast<const uint4*>(kp_ + (size_t)256 * PW); k9 = *reinterpret_cast<const uint4*>(kp_ + (size_t)288 * PW); \
    k10 = *reinterpret_cast<const uint4*>(kp_ + (size_t)320 * PW); k11 = *reinterpret_cast<const uint4*>(kp_ + (size_t)352 * PW); \
    k12 = *reinterpret_cast<const uint4*>(kp_ + (size_t)384 * PW); k13 = *reinterpret_cast<const uint4*>(kp_ + (size_t)416 * PW); \
    k14 = *reinterpret_cast<const uint4*>(kp_ + (size_t)448 * PW); k15 = *reinterpret_cast<const uint4*>(kp_ + (size_t)480 * PW); \
    km = *reinterpret_cast<const uint4*>(pb_ + (size_t)((tid >> 3) & 15) * PW + PC_NAK + h_ * 64 + (tid & 7) * 8);    \
    const u16* qp_ = pb_ + (size_t)(NMETA + r_ * 64 + wv * 16 + l16) * PW + PC_NAQ + h_ * 64 + quad * 8;            \
    qf0 = ld8(qp_); qf1 = ld8(qp_ + 32);                                                                             \
    kbias = p.rel_bias[h_ * 465 + (kr0_ - r_ + 7 + brow_) * 31 + bcol_];                                            \
  }
  int item = first_item;
  { const int it0 = item < 8192 ? item : 0; NA_KLOAD(it0); }
  for (; item < 8192; item += stride) {
    const int h = item & 7, r = (item >> 3) & 127, b = item >> 10;
    const int kr0 = min(max(r - 4, 0), 120);
    u16* proj = p.proj + (size_t)b * LL * PW;
    __syncthreads();
    {
      u16* kd = KL + (tid >> 3) * 64 + (((tid & 7) ^ ((tid >> 3) & 7)) * 8);
      *reinterpret_cast<uint4*>(kd) = k0; *reinterpret_cast<uint4*>(kd + 32 * 64) = k1; *reinterpret_cast<uint4*>(kd + 64 * 64) = k2;
      *reinterpret_cast<uint4*>(kd + 96 * 64) = k3; *reinterpret_cast<uint4*>(kd + 128 * 64) = k4; *reinterpret_cast<uint4*>(kd + 160 * 64) = k5;
      *reinterpret_cast<uint4*>(kd + 192 * 64) = k6; *reinterpret_cast<uint4*>(kd + 224 * 64) = k7; *reinterpret_cast<uint4*>(kd + 256 * 64) = k8;
      *reinterpret_cast<uint4*>(kd + 288 * 64) = k9; *reinterpret_cast<uint4*>(kd + 320 * 64) = k10; *reinterpret_cast<uint4*>(kd + 352 * 64) = k11;
      *reinterpret_cast<uint4*>(kd + 384 * 64) = k12; *reinterpret_cast<uint4*>(kd + 416 * 64) = k13; *reinterpret_cast<uint4*>(kd + 448 * 64) = k14;
      *reinterpret_cast<uint4*>(kd + 480 * 64) = k15;
      if (tid < 128) *reinterpret_cast<uint4*>(kd + 512 * 64) = km;
      if (tid < 248) BL[brow_ * 32 + bcol_] = kbias;
    }
    __syncthreads();
    uint4 v0, v1, v2, v3, v4, v5, v6, v7, vm;
    const u16* vb = p.Vt + (size_t)(b * 512 + h * 64) * LL;
    const u16* vp = vb + (size_t)(tid >> 6) * LL + NMETA + kr0 * 64 + (tid & 63) * 8;
    {
      v0 = *reinterpret_cast<const uint4*>(vp); v1 = *reinterpret_cast<const uint4*>(vp + (size_t)4 * LL);
      v2 = *reinterpret_cast<const uint4*>(vp + (size_t)8 * LL); v3 = *reinterpret_cast<const uint4*>(vp + (size_t)12 * LL);
      vm = *reinterpret_cast<const uint4*>(vb + (size_t)((tid >> 1) & 63) * LL + (tid & 1) * 8);
      v4 = *reinterpret_cast<const uint4*>(vp + (size_t)16 * LL); v5 = *reinterpret_cast<const uint4*>(vp + (size_t)20 * LL);
      v6 = *reinterpret_cast<const uint4*>(vp + (size_t)24 * LL); v7 = *reinterpret_cast<const uint4*>(vp + (size_t)28 * LL);
    }
    f32x4 sc[25];
    {
      int dco[12]; bool inm[12];
#pragma unroll
      for (int jj = 0; jj < 3; ++jj)
#pragma unroll
        for (int j = 0; j < 4; ++j) {
          const int kc = (jb0 + jj) * 16 + quad * 4 + j;
          dco[jj * 4 + j] = min(max(kc - qc, -15), 15) + 15;
          inm[jj * 4 + j] = (kc >= cs) && (kc < cs + 16);
        }
      const u16* kbase = KL + (jb0 * 16 + l16) * 64;
      const int ko0 = ((quad ^ (l16 & 7)) * 8), ko1 = (((4 + quad) ^ (l16 & 7)) * 8);
#pragma unroll
      for (int i = 0; i < 8; ++i) {
#pragma unroll
        for (int jj = 0; jj < 3; ++jj) {
          const u16* kp = kbase + (i * 64 + jj * 16) * 64;
          f32x4 a = f32x4{0.f, 0.f, 0.f, 0.f};
          a = mfma16(ld8(kp + ko0), qf0, a);
          a = mfma16(ld8(kp + ko1), qf1, a);
#pragma unroll
          for (int j = 0; j < 4; ++j) a[j] = inm[jj * 4 + j] ? (a[j] + BL[i * 32 + dco[jj * 4 + j]]) : -1e30f;
          sc[i * 3 + jj] = a;
        }
        asm volatile("" ::: "memory");
      }
    }
    {
      const u16* kp = KL + (512 + l16) * 64;
      f32x4 a = f32x4{0.f, 0.f, 0.f, 0.f};
      a = mfma16(ld8(kp + ((quad ^ (l16 & 7)) * 8)), qf0, a);
      a = mfma16(ld8(kp + (((4 + quad) ^ (l16 & 7)) * 8)), qf1, a);
      sc[24] = a;
    }
    float mx = -1e30f;
#pragma unroll
    for (int t = 0; t < 25; ++t)
#pragma unroll
      for (int j = 0; j < 4; ++j) mx = fmaxf(mx, sc[t][j]);
    mx = fmaxf(mx, __shfl_xor(mx, 16));
    mx = fmaxf(mx, __shfl_xor(mx, 32));
    float sum = 0.f;
#pragma unroll
    for (int t = 0; t < 25; ++t)
#pragma unroll
      for (int j = 0; j < 4; ++j) { float e = __expf(sc[t][j] - mx); sc[t][j] = e; sum += e; }
    sum += __shfl_xor(sum, 16);
    sum += __shfl_xor(sum, 32);
    const float inv = 1.f / sum;
    bf16x8 pf[13];
#pragma unroll
    for (int pr = 0; pr < 12; ++pr) pf[pr] = pack8(sc[2 * pr], sc[2 * pr + 1]);
    pf[12] = pack8(sc[24], f32x4{0.f, 0.f, 0.f, 0.f});
    asm volatile("" ::: "memory");
    uint4 v8, v9, v10, v11, v12, v13, v14, v15;
    {
      v8 = *reinterpret_cast<const uint4*>(vp + (size_t)32 * LL); v9 = *reinterpret_cast<const uint4*>(vp + (size_t)36 * LL);
      v10 = *reinterpret_cast<const uint4*>(vp + (size_t)40 * LL); v11 = *reinterpret_cast<const uint4*>(vp + (size_t)44 * LL);
      v12 = *reinterpret_cast<const uint4*>(vp + (size_t)48 * LL); v13 = *reinterpret_cast<const uint4*>(vp + (size_t)52 * LL);
      v14 = *reinterpret_cast<const uint4*>(vp + (size_t)56 * LL); v15 = *reinterpret_cast<const uint4*>(vp + (size_t)60 * LL);
    }
    __syncthreads();
    u16* vd = VT + (tid >> 6) * NA_VS + (tid & 63) * 8;
    {
      *reinterpret_cast<uint4*>(vd) = v0; *reinterpret_cast<uint4*>(vd + 4 * NA_VS) = v1; *reinterpret_cast<uint4*>(vd + 8 * NA_VS) = v2;
      *reinterpret_cast<uint4*>(vd + 12 * NA_VS) = v3;
      if (tid < 128) *reinterpret_cast<uint4*>(VT + (tid >> 1) * NA_VS + 512 + (tid & 1) * 8) = vm;
    }
    __syncthreads();
    const int qtok = NMETA + r * 64 + wv * 16 + l16;
    f32x4 o[4];
#pragma unroll
    for (int d = 0; d < 4; ++d) o[d] = f32x4{0.f, 0.f, 0.f, 0.f};
#define NA_PV(d_lo, d_hi)                                                                       \
    {                                                                                           \
      _Pragma("unroll") for (int pr = 0; pr < 12; ++pr) {                                       \
        const int t0 = 2 * pr, t1 = 2 * pr + 1;                                                 \
        const int tokA = (t0 / 3) * 64 + (jb0 + t0 % 3) * 16 + quad * 4;                        \
        const int tokB = (t1 / 3) * 64 + (jb0 + t1 % 3) * 16 + quad * 4;                        \
        _Pragma("unroll") for (int d = d_lo; d < d_hi; ++d) {                                   \
          const u16* vr = VT + (d * 16 + l16) * NA_VS;                                          \
          o[d] = mfma16(ld4x2(vr + tokA, vr + tokB), pf[pr], o[d]);                             \
        }                                                                                       \
        if (pr % 2 == 1) asm volatile("" ::: "memory");                                         \
      }                                                                                         \
      _Pragma("unroll") for (int d = d_lo; d < d_hi; ++d) {                                     \
        const u16* vr = VT + (d * 16 + l16) * NA_VS + 512 + quad * 4;                           \
        union { bf16x8 v; uint2 u[2]; } vf;                                                     \
        vf.u[0] = *reinterpret_cast<const uint2*>(vr);                                          \
        vf.u[1] = make_uint2(0u, 0u);                                                           \
        o[d] = mfma16(vf.v, pf[12], o[d]);                                                      \
      }                                                                                         \
    }
    NA_PV(0, 1);
    {
      *reinterpret_cast<uint4*>(vd + 16 * NA_VS) = v4; *reinterpret_cast<uint4*>(vd + 20 * NA_VS) = v5;
      *reinterpret_cast<uint4*>(vd + 24 * NA_VS) = v6; *reinterpret_cast<uint4*>(vd + 28 * NA_VS) = v7;
      *reinterpret_cast<uint4*>(vd + 32 * NA_VS) = v8; *reinterpret_cast<uint4*>(vd + 36 * NA_VS) = v9; *reinterpret_cast<uint4*>(vd + 40 * NA_VS) = v10;
      *reinterpret_cast<uint4*>(vd + 44 * NA_VS) = v11; *reinterpret_cast<uint4*>(vd + 48 * NA_VS) = v12; *reinterpret_cast<uint4*>(vd + 52 * NA_VS) = v13;
      *reinterpret_cast<uint4*>(vd + 56 * NA_VS) = v14; *reinterpret_cast<uint4*>(vd + 60 * NA_VS) = v15;
    }
    __syncthreads();
    {
      const int nx = (item + stride < 8192) ? (item + stride) : item;
      NA_KLOAD(nx);
    }
    NA_PV(1, 4);
#undef NA_PV
#pragma unroll
    for (int d = 0; d < 4; ++d) {
      f32x4 v = o[d] * inv;
      *reinterpret_cast<uint2*>(proj + (size_t)qtok * PW + PC_NAQ + h * 64 + d * 16 + quad * 4) = pack4(v);
    }
  }
#undef NA_KLOAD
  for (; item < 8192 + 64; item += stride)
    if (wv == 0) na_wave<0>(p, (item - 8192) >> 3, item & 7, 0, 0, 0, 0, 0);
}

__device__ void dn_prep(const Params& p, int item, char* smem, const int tid_in) {
  int tid = tid_in;
  asm volatile("" : "+v"(tid));
  const int h = item & 3, n = (item >> 2) % NCH, b = item / (4 * NCH);
  const int lane = tid & 63, wv = tid >> 6, l16 = lane & 15, quad = lane >> 4;
  u16* qL = (u16*)smem;
  u16* kL = qL + 64 * 144;
  float* G1 = (float*)smem;
  float* G2 = G1 + 64 * 68;
  u16* Tb = (u16*)smem;
  u16* kT = (u16*)(smem + 36864);
  u16* vT = kT + 128 * 72;
  float* vec = (float*)(smem + 36864 + 36864);
  float* gcv = vec;
  float* btv = vec + 128;
  const size_t cidx = (size_t)(b * 4 + h) * NCH + n;
  const size_t dcf = ((size_t)(b * 4 + h) * 2 + 0) * NCH + n;
  const size_t dcb = ((size_t)(b * 4 + h) * 2 + 1) * NCH + n;
  const int tbase = n * 64 - 48;
  __syncthreads();
  if (tid < 128) {
    const int dir = wv, c = lane;
    const int t = tbase + c;
    float beta = 0.f, g = 0.f;
    if (t >= 0) {
      const size_t m = (size_t)b * LL + t;
      float bv = bf2f(p.proj[m * PW + PC_B + dir * 4 + h]);
      float av = bf2f(p.proj[m * PW + PC_A + dir * 4 + h]);
      beta = 1.f / (1.f + expf(-bv));
      float xx = av + p.dt_bias[dir * 4 + h];
      float sp = (xx > 20.f) ? xx : log1pf(expf(xx));
      g = -expf(p.a_log[dir * 4 + h]) * sp;
    }
    float s = g;
    if (dir == 0) {
#pragma unroll
      for (int o = 1; o < 64; o <<= 1) { float y = __shfl_up(s, o); if (lane >= o) s += y; }
    } else {
#pragma unroll
      for (int o = 1; o < 64; o <<= 1) { float y = __shfl_down(s, o); if (lane + o < 64) s += y; }
    }
    gcv[dir * 64 + c] = s;
    btv[dir * 64 + c] = beta;
    const float tot = __shfl(s, dir == 0 ? 63 : 0);
    const size_t dc = dir ? dcb : dcf;
    p.egS[dc * 64 + c] = expf(s);
    p.ekS[dc * 64 + c] = expf(tot - s);
    if (lane == 0) p.cdS[dc] = expf(tot);
  }
  {
    const int cg_ = tid & 15, tg = tid >> 4;
#pragma unroll 1
    for (int pass = 0; pass < 3; ++pass) {
      const int pcol = PC_DNQ + pass * 512 + h * 128 + cg_ * 8;
      const int wcol = pass * 512 + h * 128 + cg_ * 8;
      bf16x8 xr[8];
#pragma unroll
      for (int rr = 0; rr < 8; ++rr) {
        const int t = tbase + tg * 4 - 2 + rr;
        if (t >= 0 && t < LL) xr[rr] = ld8(p.proj + ((size_t)b * LL + t) * PW + pcol);
        else xr[rr] = bf16x8{0, 0, 0, 0, 0, 0, 0, 0};
      }
      float y[4][8];
#pragma unroll
      for (int o = 0; o < 4; ++o)
#pragma unroll
        for (int e = 0; e < 8; ++e) y[o][e] = 0.f;
      float wgt[5][8];
#pragma unroll
      for (int i = 0; i < 5; ++i) {
        float4 w0 = *reinterpret_cast<const float4*>(p.conv_w + (size_t)i * 1536 + wcol);
        float4 w1 = *reinterpret_cast<const float4*>(p.conv_w + (size_t)i * 1536 + wcol + 4);
        wgt[i][0] = w0.x; wgt[i][1] = w0.y; wgt[i][2] = w0.z; wgt[i][3] = w0.w; wgt[i][4] = w1.x; wgt[i][5] = w1.y; wgt[i][6] = w1.z; wgt[i][7] = w1.w;
      }
#pragma unroll
      for (int rr = 0; rr < 8; ++rr) {
        float xf[8];
#pragma unroll
        for (int e = 0; e < 8; ++e) xf[e] = bf2f((u16)xr[rr][e]);
#pragma unroll
        for (int o = 0; o < 4; ++o) {
          const int i = rr - o;
          if (i >= 0 && i < 5) {
#pragma unroll
            for (int e = 0; e < 8; ++e) y[o][e] += wgt[i][e] * xf[e];
          }
        }
      }
#pragma unroll
      for (int o = 0; o < 4; ++o) {
        const int t = tbase + tg * 4 + o;
        float ss = 0.f;
#pragma unroll
        for (int e = 0; e < 8; ++e) {
          float v = y[o][e];
          v = (t >= 0) ? v * __builtin_amdgcn_rcpf(1.f + __expf(-v)) : 0.f;
          y[o][e] = v;
          ss += v * v;
        }
        if (pass < 2) {
          ss += __shfl_xor(ss, 1); ss += __shfl_xor(ss, 2); ss += __shfl_xor(ss, 4); ss += __shfl_xor(ss, 8);
          float sc = rsqrtf(ss + EPSF);
          if (pass == 0) sc *= 0.08838834764831845f;
#pragma unroll
          for (int e = 0; e < 8; ++e) y[o][e] *= sc;
          const int c = tg * 4 + o;
          uint4 pk = make_uint4(pack2(y[o][0], y[o][1]), pack2(y[o][2], y[o][3]), pack2(y[o][4], y[o][5]), pack2(y[o][6], y[o][7]));
          u16* dstL = pass == 0 ? qL : kL;
          *reinterpret_cast<uint4*>(dstL + c * 144 + cg_ * 8) = pk;
          if (pass == 0) {
            u16* gq = p.qn + cidx * 8192 + (size_t)c * 128;
            *reinterpret_cast<uint2*>(gq + sigma(cg_ * 8)) = make_uint2(pk.x, pk.y);
            *reinterpret_cast<uint2*>(gq + sigma(cg_ * 8 + 4)) = make_uint2(pk.z, pk.w);
          }
        }
      }
      if (pass >= 1) {
        u16* dT = (pass == 1 ? kT : vT) + sigma(tg * 4);
#pragma unroll
        for (int e = 0; e < 8; ++e)
          *reinterpret_cast<uint2*>(dT + (cg_ * 8 + e) * 72) = make_uint2(pack2(y[0][e], y[1][e]), pack2(y[2][e], y[3][e]));
      }
    }
  }
  __syncthreads();
  {
    const int row = tid >> 1, half = tid & 1;
    const uint4* s4 = reinterpret_cast<const uint4*>(kT + row * 72 + half * 32);
    uint4* d4 = reinterpret_cast<uint4*>(p.knT + cidx * 8192 + (size_t)row * 64 + half * 32);
    d4[0] = s4[0]; d4[1] = s4[1]; d4[2] = s4[2]; d4[3] = s4[3];
  }
  f32x4 kk[4], qk[4];
  {
#pragma unroll
    for (int jt = 0; jt < 4; ++jt) { kk[jt] = f32x4{0.f, 0.f, 0.f, 0.f}; qk[jt] = f32x4{0.f, 0.f, 0.f, 0.f}; }
#pragma unroll
    for (int ks = 0; ks < 4; ++ks) {
      bf16x8 bq = ld8(qL + (wv * 16 + l16) * 144 + ks * 32 + quad * 8);
      bf16x8 bk = ld8(kL + (wv * 16 + l16) * 144 + ks * 32 + quad * 8);
#pragma unroll
      for (int jt = 0; jt < 4; ++jt) {
        bf16x8 a = ld8(kL + (jt * 16 + l16) * 144 + ks * 32 + quad * 8);
        kk[jt] = mfma16(a, bk, kk[jt]);
        qk[jt] = mfma16(a, bq, qk[jt]);
      }
    }
  }
  __syncthreads();
  {
    const int i = wv * 16 + l16;
    const float gfi = gcv[i], gbi = gcv[64 + i], bfi = btv[i], bbi = btv[64 + i];
#pragma unroll
    for (int jt = 0; jt < 4; ++jt) {
      const int j0 = jt * 16 + quad * 4;
      f32x4 mf, mb, qf, qb;
#pragma unroll
      for (int jj = 0; jj < 4; ++jj) {
        const int j = j0 + jj;
        const float df = __expf(gfi - gcv[j]);
        const float db = __expf(gbi - gcv[64 + j]);
        mf[jj] = (i > j) ? bfi * kk[jt][jj] * df : 0.f;
        mb[jj] = (i < j) ? bbi * kk[jt][jj] * db : 0.f;
        qf[jj] = (i >= j) ? qk[jt][jj] * df : 0.f;
        qb[jj] = (i <= j) ? qk[jt][jj] * db : 0.f;
      }
      *reinterpret_cast<float4*>(G1 + i * 68 + j0) = make_float4(mf[0], mf[1], mf[2], mf[3]);
      *reinterpret_cast<float4*>(G2 + (63 - i) * 68 + (60 - j0)) = make_float4(mb[3], mb[2], mb[1], mb[0]);
      *reinterpret_cast<uint2*>(p.qkS + dcf * 4096 + (size_t)i * 64 + sigma(j0)) = pack4(qf);
      *reinterpret_cast<uint2*>(p.qkS + dcb * 4096 + (size_t)i * 64 + sigma(j0)) = pack4(qb);
    }
  }
  __syncthreads();
  if (wv < 2) {
    float* G = (wv == 0 ? G1 : G2) + (quad * 16) * 68 + quad * 16;
    float t[16];
#pragma unroll
    for (int i = 0; i < 16; ++i) {
      float a = (i == l16) ? 1.f : 0.f;
#pragma unroll
      for (int j = 0; j < i; ++j) a -= G[i * 68 + j] * t[j];
      t[i] = a;
      asm volatile("" ::: "memory");
    }
#pragma unroll
    for (int i = 0; i < 16; ++i) G[i * 68 + l16] = t[i];
  }
  __syncthreads();
  {
    float* G = ((wv >> 1) ? G2 : G1) + ((wv & 1) * 32) * 68 + (wv & 1) * 32;
    f32x4 x = f32x4{0.f, 0.f, 0.f, 0.f};
#pragma unroll
    for (int st = 0; st < 4; ++st)
      x = __builtin_amdgcn_mfma_f32_16x16x4f32(G[(16 + l16) * 68 + 4 * st + quad], G[(4 * st + quad) * 68 + l16], x, 0, 0, 0);
    f32x4 yv = f32x4{0.f, 0.f, 0.f, 0.f};
#pragma unroll
    for (int j = 0; j < 4; ++j)
      yv = __builtin_amdgcn_mfma_f32_16x16x4f32(G[(16 + l16) * 68 + 16 + 4 * quad + j], x[j], yv, 0, 0, 0);
#pragma unroll
    for (int j = 0; j < 4; ++j) G[(16 + quad * 4 + j) * 68 + l16] = -yv[j];
  }
  __syncthreads();
  {
    float* G = (wv >> 1) ? G2 : G1;
    const int cb = wv & 1;
    f32x4 x0 = f32x4{0.f, 0.f, 0.f, 0.f}, x1 = f32x4{0.f, 0.f, 0.f, 0.f};
#pragma unroll
    for (int st = 0; st < 8; ++st) {
      const float bv = G[(4 * st + quad) * 68 + cb * 16 + l16];
      x0 = __builtin_amdgcn_mfma_f32_16x16x4f32(G[(32 + l16) * 68 + 4 * st + quad], bv, x0, 0, 0, 0);
      x1 = __builtin_amdgcn_mfma_f32_16x16x4f32(G[(48 + l16) * 68 + 4 * st + quad], bv, x1, 0, 0, 0);
    }
    __syncthreads();
    f32x4 y0 = f32x4{0.f, 0.f, 0.f, 0.f}, y1 = f32x4{0.f, 0.f, 0.f, 0.f};
#pragma unroll
    for (int j = 0; j < 4; ++j) {
      y0 = __builtin_amdgcn_mfma_f32_16x16x4f32(G[(32 + l16) * 68 + 32 + 4 * quad + j], x0[j], y0, 0, 0, 0);
      y0 = __builtin_amdgcn_mfma_f32_16x16x4f32(G[(32 + l16) * 68 + 48 + 4 * quad + j], x1[j], y0, 0, 0, 0);
      y1 = __builtin_amdgcn_mfma_f32_16x16x4f32(G[(48 + l16) * 68 + 32 + 4 * quad + j], x0[j], y1, 0, 0, 0);
      y1 = __builtin_amdgcn_mfma_f32_16x16x4f32(G[(48 + l16) * 68 + 48 + 4 * quad + j], x1[j], y1, 0, 0, 0);
    }
#pragma unroll
    for (int j = 0; j < 4; ++j) {
      G[(32 + quad * 4 + j) * 68 + cb * 16 + l16] = -y0[j];
      G[(48 + quad * 4 + j) * 68 + cb * 16 + l16] = -y1[j];
    }
  }
  __syncthreads();
  {
    const int dir = wv >> 1, rh = wv & 1;
    const float* G = dir ? G2 : G1;
    float T[32];
#pragma unroll
    for (int i = 0; i < 32; ++i) T[i] = G[(rh * 32 + i) * 68 + lane];
    __syncthreads();
    const int jcol = dir == 0 ? lane : 63 - lane;
    const float bt = btv[dir * 64 + jcol];
    const float eg = expf(gcv[dir * 64 + jcol]);
    u16* Tu = Tb + (dir * 2 + 0) * (64 * 72);
    u16* Tw = Tb + (dir * 2 + 1) * (64 * 72);
    const int sj = sigma(jcol);
#pragma unroll
    for (int i = 0; i < 32; ++i) {
      const int i0 = rh * 32 + i;
      const int irow = dir == 0 ? i0 : 63 - i0;
      Tu[irow * 72 + sj] = f2bf(T[i] * bt);
      Tw[irow * 72 + sj] = f2bf(T[i] * bt * eg);
    }
  }
  __syncthreads();
  {
    const int dir = wv >> 1, which = wv & 1;
    const u16* Tm = Tb + (dir * 2 + which) * (64 * 72);
    const size_t dc = dir ? dcb : dcf;
    if (which == 0) {
      u16* dst = p.uT + dc * 8192;
#pragma unroll 1
      for (int dt = 0; dt < 8; ++dt) {
        bf16x8 b0 = ld8(vT + (dt * 16 + l16) * 72 + quad * 8);
        bf16x8 b1 = ld8(vT + (dt * 16 + l16) * 72 + 32 + quad * 8);
#pragma unroll
        for (int it = 0; it < 4; ++it) {
          f32x4 a = f32x4{0.f, 0.f, 0.f, 0.f};
          a = mfma16(ld8(Tm + (it * 16 + l16) * 72 + quad * 8), b0, a);
          a = mfma16(ld8(Tm + (it * 16 + l16) * 72 + 32 + quad * 8), b1, a);
          *reinterpret_cast<uint2*>(dst + (size_t)(dt * 16 + l16) * 64 + it * 16 + quad * 4) = pack4(a);
        }
      }
    } else {
      u16* dst = p.wS + dc * 8192;
#pragma unroll 1
      for (int dt = 0; dt < 8; ++dt) {
        bf16x8 a0 = ld8(kT + (dt * 16 + l16) * 72 + quad * 8);
        bf16x8 a1 = ld8(kT + (dt * 16 + l16) * 72 + 32 + quad * 8);
#pragma unroll
        for (int it = 0; it < 4; ++it) {
          f32x4 a = f32x4{0.f, 0.f, 0.f, 0.f};
          a = mfma16(a0, ld8(Tm + (it * 16 + l16) * 72 + quad * 8), a);
          a = mfma16(a1, ld8(Tm + (it * 16 + l16) * 72 + 32 + quad * 8), a);
          *reinterpret_cast<uint2*>(dst + (size_t)(it * 16 + l16) * 128 + sigma(dt * 16 + quad * 4)) = pack4(a);
        }
      }
    }
  }
}

constexpr int SC_WS = 288, SC_KS = 160;
constexpr int SC_W = 0, SC_Q = 64 * SC_WS, SC_K = 2 * 64 * SC_WS, SC_QK = SC_K + 128 * SC_KS, SC_E = SC_QK + 64 * SC_KS, SC_BUF = SC_E + 768;
__device__ void dn_scan_block(const Params& p, const int chain, char* smem, const int tid) {
  const int lane = tid & 63, l16 = lane & 15, quad = lane >> 4, wv = tid >> 6;
  const int dir = chain & 1, bh = chain >> 1;
  __syncthreads();
  if (wv >= 4) {
    const int lt = tid - 256;
    uint4 r0, r1, r2, r3, r4, r5, r6, r7, r8, r9, r10, r11, r12, r13, re;
    float rc;
    const int dwq = (lt >> 4) * SC_WS + (lt & 15) * 16;
    const int dkk = (lt >> 3) * SC_KS + (lt & 7) * 16;
#define SCAN_GLOAD(n_)                                                                                   \
    {                                                                                                    \
      const size_t cidx_ = (size_t)bh * NCH + (n_);                                                      \
      const size_t dc_ = ((size_t)bh * 2 + dir) * NCH + (n_);                                            \
      const uint4* w4 = reinterpret_cast<const uint4*>(p.wS + dc_ * 8192) + lt;                          \
      const uint4* q4 = reinterpret_cast<const uint4*>(p.qn + cidx_ * 8192) + lt;                        \
      const uint4* k4 = reinterpret_cast<const uint4*>(p.knT + cidx_ * 8192) + lt;                       \
      const uint4* g4 = reinterpret_cast<const uint4*>(p.qkS + dc_ * 4096) + lt;                         \
      r0 = w4[0]; r1 = w4[256]; r2 = w4[512]; r3 = w4[768];                                              \
      r4 = q4[0]; r5 = q4[256]; r6 = q4[512]; r7 = q4[768];                                              \
      r8 = k4[0]; r9 = k4[256]; r10 = k4[512]; r11 = k4[768];                                            \
      r12 = g4[0]; r13 = g4[256];                                                                        \
      re = reinterpret_cast<const uint4*>((lt < 16 ? p.egS : p.ekS) + dc_ * 64)[lt & 15];               \
      rc = p.cdS[dc_];                                                                                   \
    }
#define SCAN_SSTORE(buf_)                                                                                \
    {                                                                                                    \
      char* bb_ = smem + (buf_) * SC_BUF;                                                                \
      *reinterpret_cast<uint4*>(bb_ + SC_W + dwq) = r0; *reinterpret_cast<uint4*>(bb_ + SC_W + dwq + 16 * SC_WS) = r1; \
      *reinterpret_cast<uint4*>(bb_ + SC_W + dwq + 32 * SC_WS) = r2; *reinterpret_cast<uint4*>(bb_ + SC_W + dwq + 48 * SC_WS) = r3; \
      *reinterpret_cast<uint4*>(bb_ + SC_Q + dwq) = r4; *reinterpret_cast<uint4*>(bb_ + SC_Q + dwq + 16 * SC_WS) = r5; \
      *reinterpret_cast<uint4*>(bb_ + SC_Q + dwq + 32 * SC_WS) = r6; *reinterpret_cast<uint4*>(bb_ + SC_Q + dwq + 48 * SC_WS) = r7; \
      *reinterpret_cast<uint4*>(bb_ + SC_K + dkk) = r8; *reinterpret_cast<uint4*>(bb_ + SC_K + dkk + 32 * SC_KS) = r9; \
      *reinterpret_cast<uint4*>(bb_ + SC_K + dkk + 64 * SC_KS) = r10; *reinterpret_cast<uint4*>(bb_ + SC_K + dkk + 96 * SC_KS) = r11; \
      *reinterpret_cast<uint4*>(bb_ + SC_QK + dkk) = r12; *reinterpret_cast<uint4*>(bb_ + SC_QK + dkk + 32 * SC_KS) = r13; \
      if (lt < 32) *reinterpret_cast<uint4*>(bb_ + SC_E + lt * 16) = re;                                  \
      if (lt == 32) *reinterpret_cast<float*>(bb_ + SC_E + 512) = rc;                                     \
    }
    SCAN_GLOAD(dir ? (NCH - 1) : 0);
    SCAN_SSTORE(0);
    SCAN_GLOAD(dir ? (NCH - 2) : 1);
    __syncthreads();
#pragma unroll 1
    for (int step = 0; step < NCH; ++step) {
      if (step + 1 < NCH) {
        SCAN_SSTORE((step + 1) & 1);
        const int s2 = min(step + 2, NCH - 1);
        SCAN_GLOAD(dir ? (NCH - 1 - s2) : s2);
      }
      __syncthreads();
    }
#undef SCAN_GLOAD
#undef SCAN_SSTORE
  } else {
    f32x4 S0[8], S1[8];
#pragma unroll
    for (int k = 0; k < 8; ++k) { S0[k] = f32x4{0.f, 0.f, 0.f, 0.f}; S1[k] = f32x4{0.f, 0.f, 0.f, 0.f}; }
    uint2 un00, un01, un02, un03, un10, un11, un12, un13;
#define SCAN_ULOAD(n_)                                                                                   \
    {                                                                                                    \
      const size_t dc_ = ((size_t)bh * 2 + dir) * NCH + (n_);                                            \
      const u16* up_ = p.uT + dc_ * 8192 + (size_t)(wv * 32 + l16) * 64 + quad * 4;                      \
      un00 = *reinterpret_cast<const uint2*>(up_); un01 = *reinterpret_cast<const uint2*>(up_ + 16);     \
      un02 = *reinterpret_cast<const uint2*>(up_ + 32); un03 = *reinterpret_cast<const uint2*>(up_ + 48); \
      un10 = *reinterpret_cast<const uint2*>(up_ + 1024); un11 = *reinterpret_cast<const uint2*>(up_ + 1040); \
      un12 = *reinterpret_cast<const uint2*>(up_ + 1056); un13 = *reinterpret_cast<const uint2*>(up_ + 1072); \
    }
    SCAN_ULOAD(dir ? (NCH - 1) : 0);
    __syncthreads();
#pragma unroll 1
    for (int step = 0; step < NCH; ++step) {
      const int n = dir ? (NCH - 1 - step) : step;
      const size_t dc = ((size_t)bh * 2 + dir) * NCH + n;
      const uint2 uc00 = un00, uc01 = un01, uc02 = un02, uc03 = un03, uc10 = un10, uc11 = un11, uc12 = un12, uc13 = un13;
      {
        const int s1 = min(step + 1, NCH - 1);
        SCAN_ULOAD(dir ? (NCH - 1 - s1) : s1);
      }
      const char* bb = smem + (step & 1) * SC_BUF;
      const u16* wp = reinterpret_cast<const u16*>(bb + SC_W);
      const u16* qp = reinterpret_cast<const u16*>(bb + SC_Q);
      const u16* kp = reinterpret_cast<const u16*>(bb + SC_K);
      const u16* qkp = reinterpret_cast<const u16*>(bb + SC_QK);
      const float* egp = reinterpret_cast<const float*>(bb + SC_E);
      const float* ekp = egp + 64;
      const float cd = egp[128];
      u16* up = p.uT + dc * 8192 + (size_t)(wv * 32 + l16) * 64;
      bf16x8 Sb0[4], Sb1[4];
#pragma unroll
      for (int ks = 0; ks < 4; ++ks) { Sb0[ks] = pack8(S0[2 * ks], S0[2 * ks + 1]); Sb1[ks] = pack8(S1[2 * ks], S1[2 * ks + 1]); }
      f32x4 vn0[4], vn1[4], oa0[4], oa1[4];
#pragma unroll
      for (int ct = 0; ct < 4; ++ct) {
        f32x4 a0 = f32x4{0.f, 0.f, 0.f, 0.f}, a1 = a0;
#pragma unroll
        for (int ks = 0; ks < 4; ++ks) {
          const bf16x8 wf = ld8(wp + (ct * 16 + l16) * (SC_WS / 2) + ks * 32 + quad * 8);
          a0 = mfma16(wf, Sb0[ks], a0); a1 = mfma16(wf, Sb1[ks], a1);
        }
        const uint2 u0 = (ct == 0) ? uc00 : (ct == 1) ? uc01 : (ct == 2) ? uc02 : uc03;
        const uint2 u1 = (ct == 0) ? uc10 : (ct == 1) ? uc11 : (ct == 2) ? uc12 : uc13;
        vn0[ct][0] = bf2f((u16)(u0.x & 0xffff)) - a0[0]; vn0[ct][1] = bf2f((u16)(u0.x >> 16)) - a0[1];
        vn0[ct][2] = bf2f((u16)(u0.y & 0xffff)) - a0[2]; vn0[ct][3] = bf2f((u16)(u0.y >> 16)) - a0[3];
        vn1[ct][0] = bf2f((u16)(u1.x & 0xffff)) - a1[0]; vn1[ct][1] = bf2f((u16)(u1.x >> 16)) - a1[1];
        vn1[ct][2] = bf2f((u16)(u1.y & 0xffff)) - a1[2]; vn1[ct][3] = bf2f((u16)(u1.y >> 16)) - a1[3];
      }
#pragma unroll
      for (int ct = 0; ct < 4; ++ct) {
        f32x4 o0 = f32x4{0.f, 0.f, 0.f, 0.f}, o1 = o0;
#pragma unroll
        for (int ks = 0; ks < 4; ++ks) {
          const bf16x8 qf = ld8(qp + (ct * 16 + l16) * (SC_WS / 2) + ks * 32 + quad * 8);
          o0 = mfma16(qf, Sb0[ks], o0); o1 = mfma16(qf, Sb1[ks], o1);
        }
        const float4 eg = *reinterpret_cast<const float4*>(egp + ct * 16 + quad * 4);
        oa0[ct][0] = o0[0] * eg.x; oa0[ct][1] = o0[1] * eg.y; oa0[ct][2] = o0[2] * eg.z; oa0[ct][3] = o0[3] * eg.w;
        oa1[ct][0] = o1[0] * eg.x; oa1[ct][1] = o1[1] * eg.y; oa1[ct][2] = o1[2] * eg.z; oa1[ct][3] = o1[3] * eg.w;
      }
      bf16x8 Vb0[2], Vb1[2], Eb0[2], Eb1[2];
#pragma unroll
      for (int k2 = 0; k2 < 2; ++k2) {
        Vb0[k2] = pack8(vn0[2 * k2], vn0[2 * k2 + 1]);
        Vb1[k2] = pack8(vn1[2 * k2], vn1[2 * k2 + 1]);
        const float4 e0 = *reinterpret_cast<const float4*>(ekp + (2 * k2) * 16 + quad * 4);
        const float4 e1 = *reinterpret_cast<const float4*>(ekp + (2 * k2 + 1) * 16 + quad * 4);
        f32x4 x0 = vn0[2 * k2], x1 = vn0[2 * k2 + 1], y0 = vn1[2 * k2], y1 = vn1[2 * k2 + 1];
        x0[0] *= e0.x; x0[1] *= e0.y; x0[2] *= e0.z; x0[3] *= e0.w;
        x1[0] *= e1.x; x1[1] *= e1.y; x1[2] *= e1.z; x1[3] *= e1.w;
        y0[0] *= e0.x; y0[1] *= e0.y; y0[2] *= e0.z; y0[3] *= e0.w;
        y1[0] *= e1.x; y1[1] *= e1.y; y1[2] *= e1.z; y1[3] *= e1.w;
        Eb0[k2] = pack8(x0, x1);
        Eb1[k2] = pack8(y0, y1);
      }
#pragma unroll
      for (int ct = 0; ct < 4; ++ct) {
        f32x4 o0 = oa0[ct], o1 = oa1[ct];
#pragma unroll
        for (int k2 = 0; k2 < 2; ++k2) {
          const bf16x8 gf = ld8(qkp + (ct * 16 + l16) * (SC_KS / 2) + k2 * 32 + quad * 8);
          o0 = mfma16(gf, Vb0[k2], o0); o1 = mfma16(gf, Vb1[k2], o1);
        }
        *reinterpret_cast<uint2*>(up + ct * 16 + quad * 4) = pack4(o0);
        *reinterpret_cast<uint2*>(up + 1024 + ct * 16 + quad * 4) = pack4(o1);
      }
#pragma unroll
      for (int kt = 0; kt < 8; ++kt) {
        f32x4 s0 = S0[kt] * cd, s1 = S1[kt] * cd;
#pragma unroll
        for (int k2 = 0; k2 < 2; ++k2) {
          const bf16x8 kf = ld8(kp + (kt * 16 + l16) * (SC_KS / 2) + k2 * 32 + quad * 8);
          s0 = mfma16(kf, Eb0[k2], s0); s1 = mfma16(kf, Eb1[k2], s1);
        }
        S0[kt] = s0; S1[kt] = s1;
      }
      __syncthreads();
    }
#undef SCAN_ULOAD
  }
}

__device__ void dn_combine(const Params& p, int item, char* smem, const int tid) {
  const int h = item & 3, n = (item >> 2) % NCH, b = item / (4 * NCH);
  float* sl = (float*)smem;
  const size_t dcf = ((size_t)(b * 4 + h) * 2 + 0) * NCH + n;
  const size_t dcb = ((size_t)(b * 4 + h) * 2 + 1) * NCH + n;
  const int c = tid >> 2, part = tid & 3;
  const int t = n * 64 - 48 + c;
  const size_t mrow = (size_t)b * LL + (t >= 0 ? t : 0);
  u16* dp = p.proj + mrow * PW + PC_Z + h * 128 + part * 32;
  const bf16x8 z0 = ld8(dp), z1 = ld8(dp + 8), z2 = ld8(dp + 16), z3 = ld8(dp + 24);
  __syncthreads();
#pragma unroll
  for (int i = 0; i < 4; ++i) {
    const int e8 = tid + i * 256;
    const int v = e8 >> 3, c0 = (e8 & 7) * 8;
    bf16x8 a = ld8(p.uT + dcf * 8192 + (size_t)e8 * 8);
    bf16x8 bb = ld8(p.uT + dcb * 8192 + (size_t)e8 * 8);
#pragma unroll
    for (int e = 0; e < 8; ++e) sl[v * 65 + (v >> 5) * 8 + c0 + e] = bf2f((u16)a[e]) + bf2f((u16)bb[e]);
  }
  __syncthreads();
  float vals[32];
  float ss = 0.f;
#pragma unroll
  for (int e = 0; e < 32; ++e) { float v = sl[(part * 32 + e) * 65 + part * 8 + c]; vals[e] = v; ss += v * v; }
  ss += __shfl_xor(ss, 1); ss += __shfl_xor(ss, 2);
  const float rs = rsqrtf(ss * (1.f / 128.f) + EPSF);
  if (t >= 0) {
#pragma unroll
    for (int e8 = 0; e8 < 4; ++e8) {
      const bf16x8 z = (e8 == 0) ? z0 : (e8 == 1) ? z1 : (e8 == 2) ? z2 : z3;
      float r[8];
#pragma unroll
      for (int e = 0; e < 8; ++e) {
        float zz = bf2f((u16)z[e]);
        r[e] = vals[e8 * 8 + e] * rs * p.norm_g[part * 32 + e8 * 8 + e] * (zz * __builtin_amdgcn_rcpf(1.f + __expf(-zz)));
      }
      *reinterpret_cast<uint4*>(dp + e8 * 8) = make_uint4(pack2(r[0], r[1]), pack2(r[2], r[3]), pack2(r[4], r[5]), pack2(r[6], r[7]));
    }
  }
}

__device__ void final_norm(const Params& p) {
  const int lane = threadIdx.x & 63;
  const int gw = blockIdx.x * (NTHR / 64) + (threadIdx.x >> 6), nw = gridDim.x * (NTHR / 64);
  float4 g[2][2];
#pragma unroll
  for (int q = 0; q < 2; ++q) {
    g[q][0] = *reinterpret_cast<const float4*>(p.g_final + q * 512 + lane * 8);
    g[q][1] = *reinterpret_cast<const float4*>(p.g_final + q * 512 + lane * 8 + 4);
  }
  for (int row = gw * 4; row < MC; row += nw * 4) {
    uint4 v[4][2];
    float rs[4];
#pragma unroll
    for (int r = 0; r < 4; ++r) {
      const u16* src = p.h2b + (size_t)(row + r) * DM + lane * 8;
      v[r][0] = *reinterpret_cast<const uint4*>(src); v[r][1] = *reinterpret_cast<const uint4*>(src + 512);
      rs[r] = p.ss3[row + r];
    }
#pragma unroll
    for (int r = 0; r < 4; ++r) {
      const float sc = rsqrtf(rs[r] * (1.f / DM) + EPSF);
      float* dst = p.out + (size_t)(row + r) * DM + lane * 8;
#pragma unroll
      for (int q = 0; q < 2; ++q) {
        const uint4 w = v[r][q];
        const float4 a = make_float4(__uint_as_float(w.x << 16) * sc * g[q][0].x, __uint_as_float(w.x & 0xffff0000u) * sc * g[q][0].y,
                                     __uint_as_float(w.y << 16) * sc * g[q][0].z, __uint_as_float(w.y & 0xffff0000u) * sc * g[q][0].w);
        const float4 c = make_float4(__uint_as_float(w.z << 16) * sc * g[q][1].x, __uint_as_float(w.z & 0xffff0000u) * sc * g[q][1].y,
                                     __uint_as_float(w.w << 16) * sc * g[q][1].z, __uint_as_float(w.w & 0xffff0000u) * sc * g[q][1].w);
        *reinterpret_cast<float4*>(dst + q * 512) = a;
        *reinterpret_cast<float4*>(dst + q * 512 + 4) = c;
      }
    }
  }
}

#define XB_TMO      128
#define XB_XCNT(j)  (256  + 64 * (j))
#define XB_XSUB(j)  (1280 + 64 * (j))
#define XB_XGEN(j)  (2304 + 64 * (j))
#define XB_TOP      3328
#define XB_TOPGEN   3392
#define XCD_BAR_WORDS 3456
#define XB_SPIN_CAP (1u << 18)
__device__ __forceinline__ unsigned xb_ld(unsigned* p)              { return __hip_atomic_load(p, __ATOMIC_RELAXED, __HIP_MEMORY_SCOPE_AGENT); }
__device__ __forceinline__ unsigned xb_add(unsigned* p, unsigned v) { return __hip_atomic_fetch_add(p, v, __ATOMIC_RELAXED, __HIP_MEMORY_SCOPE_AGENT); }
__device__ __forceinline__ unsigned xb_xcc_id() { return (unsigned)__builtin_amdgcn_s_getreg((3 << 11) | 20) & 0xFu; }
#define XB_SPIN(cond, bar) do { unsigned _sp = 0; while (cond) { __builtin_amdgcn_s_sleep(1); \
    if ((++_sp & 255u) == 0u) { if (xb_ld(&(bar)[XB_TMO])) break; if (_sp > XB_SPIN_CAP) { atomicAdd(&(bar)[XB_TMO], 1u); break; } } } } while (0)
struct XcdBarrier { unsigned* bar; unsigned x; volatile LAS unsigned* st; };
__device__ __forceinline__ XcdBarrier xcd_barrier_post(unsigned* bar, volatile LAS unsigned* st) {
  XcdBarrier b; b.bar = bar; b.x = xb_xcc_id(); b.st = st;
  if (threadIdx.x == 0) (void)xb_add(&bar[XB_XCNT(b.x)], 1u);
  return b;
}
__device__ __forceinline__ void xcd_barrier_complete(unsigned* bar, unsigned x, unsigned& nloc, unsigned& nx) {
  const unsigned G = gridDim.x * gridDim.y * gridDim.z;
  unsigned sum, cnt, mine, sp = 0u;
  for (;;) {
    sum = 0u; cnt = 0u; mine = 0u;
#pragma unroll
    for (unsigned j = 0; j < 16; ++j) { const unsigned c = xb_ld(&bar[XB_XCNT(j)]); sum += c; cnt += (c > 0u) ? 1u : 0u; mine = (j == x) ? c : mine; }
    if (sum == G) break;
    __builtin_amdgcn_s_sleep(1);
    if ((++sp & 255u) == 0u) { if (xb_ld(&bar[XB_TMO])) break; if (sp > XB_SPIN_CAP) { atomicAdd(&bar[XB_TMO], 1u); break; } }
  }
  nloc = mine > 0u ? mine : 1u; nx = cnt > 0u ? cnt : 1u;
}
__device__ __forceinline__ void xcd_barrier(const XcdBarrier& b) {
  asm volatile("s_waitcnt vmcnt(0)" ::: "memory");
  __syncthreads();
  if (threadIdx.x == 0) {
    unsigned* bar = b.bar;
    __builtin_amdgcn_s_waitcnt(0);
    unsigned nloc = b.st[0], nx = b.st[1];
    if (nloc == 0u) { xcd_barrier_complete(bar, b.x, nloc, nx); b.st[0] = nloc; b.st[1] = nx; }
    const unsigned old = xb_add(&bar[XB_XSUB(b.x)], 1u);
    const unsigned gen = old / nloc;
    if (old + 1u == (gen + 1u) * nloc) {
      __builtin_amdgcn_fence(__ATOMIC_RELEASE, "agent");
      asm volatile("s_waitcnt vmcnt(0)" ::: "memory");
      const unsigned og = xb_add(&bar[XB_TOP], 1u);
      const unsigned tg = og / nx;
      if (og + 1u == (tg + 1u) * nx) xb_add(&bar[XB_TOPGEN], 1u);
      else XB_SPIN(xb_ld(&bar[XB_TOPGEN]) == tg, bar);
      __builtin_amdgcn_fence(__ATOMIC_ACQUIRE, "agent");
      xb_add(&bar[XB_XGEN(b.x)], 1u);
      asm volatile("s_waitcnt vmcnt(0)" ::: "memory");
    } else {
      XB_SPIN(xb_ld(&bar[XB_XGEN(b.x)]) == gen, bar);
      __builtin_amdgcn_fence(__ATOMIC_ACQUIRE, "agent");
      asm volatile("s_waitcnt vmcnt(0)" ::: "memory");
    }
  }
  __syncthreads();
}

__global__ void __launch_bounds__(NTHR, 2) mega(Params p) {
  extern __shared__ __attribute__((aligned(16))) char smem[];
  cg::grid_group grid = cg::this_grid();
  volatile LAS unsigned* xbst = (volatile LAS unsigned*)(smem + LDS_BYTES);
  if (threadIdx.x == 0) { xbst[0] = 0u; xbst[1] = 0u; xbst[2] = 0u; xbst[3] = 0u; }
  __syncthreads();
  XcdBarrier xb; xb.bar = p.bar; xb.x = xb_xcc_id(); xb.st = xbst;
  if (blockIdx.x == 0) for (int i = threadIdx.x; i < XCD_BAR_WORDS; i += NTHR) p.bar[i] = 0u;
  const int lo = p.phase_lo, hi = p.phase_hi;
#define PH_BEGIN(n) if (lo <= (n) && (n) < hi) { if ((n) > lo) { if ((n) == 1) { grid.sync(); if (threadIdx.x == 0) (void)xb_add(&p.bar[XB_XCNT(xb.x)], 1u); } else xcd_barrier(xb); } int otid_ = threadIdx.x; asm volatile("" : "+v"(otid_)); const int half = otid_ >> 8, tid2 = otid_ & 255; char* hsm = smem + half * HLDS; (void)tid2; (void)hsm;
#define PH_END }
  PH_BEGIN(0) phase0(p, smem); PH_END
  PH_BEGIN(1) { gemm_phase<1, false>(p, (LAS unsigned char*)smem, p.hb, DM, p.WinT, INP / BM, DM); meta_inproj(p); } PH_END
  PH_BEGIN(2) {
    const int NDN = NB * NCH * 4;
    for (int it = blockIdx.x * 2 + half; it < NDN; it += gridDim.x * 2) dn_prep(p, it, hsm, tid2);
  } PH_END
  PH_BEGIN(3) {
    const bool split = gridDim.x > 64;
    const int nsc = split ? 64 : (int)gridDim.x;
    if ((int)blockIdx.x < nsc)
      for (int ch = blockIdx.x; ch < 64; ch += nsc) dn_scan_block(p, ch, smem, otid_);
    const int nb = split ? (int)blockIdx.x - 64 : (int)blockIdx.x;
    if (nb >= 0) na_items(p, hsm, tid2, nb * 2 + half, (split ? (int)gridDim.x - 64 : (int)gridDim.x) * 2);
  } PH_END
  PH_BEGIN(4) {
    for (int it = blockIdx.x * 2 + half; it < NB * NCH * 4; it += gridDim.x * 2) dn_combine(p, it, hsm, tid2);
  } PH_END
  PH_BEGIN(5) gemm_phase<3, true>(p, (LAS unsigned char*)smem, p.proj, PW, p.WoutT, DM / BM, DM); PH_END
  PH_BEGIN(6) gemm_phase<4, false>(p, (LAS unsigned char*)smem, p.h1b, DM, p.WguT, (2 * DFF) / BM, DM); PH_END
  PH_BEGIN(7) gemm_phase<5, false>(p, (LAS unsigned char*)smem, p.act, DFF, p.WdT, DM / BM, DFF); PH_END
  PH_BEGIN(8) final_norm(p); PH_END
}

static inline size_t al256(size_t v) { return (v + 255) & ~(size_t)255; }

extern "C" void kernel_launch(void* const* d_in, const int* in_sizes, int n_in, void* d_out, int out_size, void* d_ws, size_t ws_size,
                              hipStream_t stream) {
  static int grid_blocks = 0;
  if (!grid_blocks) {
    int dev = 0, cus = 0, per_cu = 0;
    hipGetDevice(&dev);
    hipDeviceGetAttribute(&cus, hipDeviceAttributeMultiprocessorCount, dev);
    hipFuncSetAttribute((const void*)mega, hipFuncAttributeMaxDynamicSharedMemorySize, LDS_BYTES + 16);
    hipOccupancyMaxActiveBlocksPerMultiprocessor(&per_cu, (const void*)mega, NTHR, LDS_BYTES + 16);
    if (per_cu < 1) per_cu = 1;
    if (per_cu > 1) per_cu = 1;
    grid_blocks = cus * per_cu;
    grid_blocks &= ~7;
    fprintf(stderr, "mega: cus %d per_cu %d grid %d ws %zu\n", cus, per_cu, grid_blocks, ws_size);
  }
  Params p{};
  p.x = (const float*)d_in[0]; p.meta = (const float*)d_in[1]; p.g_mix = (const float*)d_in[2]; p.w_in = (const float*)d_in[3];
  p.rel_bias = (const float*)d_in[4]; p.conv_w = (const float*)d_in[5]; p.a_log = (const float*)d_in[6]; p.dt_bias = (const float*)d_in[7];
  p.norm_g = (const float*)d_in[8]; p.w_out = (const float*)d_in[9]; p.g_ffn = (const float*)d_in[10]; p.w_gate = (const float*)d_in[11];
  p.w_up = (const float*)d_in[12]; p.w_down = (const float*)d_in[13]; p.g_final = (const float*)d_in[14];
  p.out = (float*)d_out;
  char* ws = (char*)d_ws;
  size_t off = 0;
  auto take = [&](size_t bytes) { char* r = ws + off; off += al256(bytes); return r; };
  p.WinT = (u16*)take((size_t)INP * DM * 2);
  p.WoutT = (u16*)take((size_t)DM * DM * 2);
  p.WguT = (u16*)take((size_t)2 * DFF * DM * 2);
  p.WdT = (u16*)take((size_t)DM * DFF * 2);
  p.bar = (unsigned*)take((size_t)XCD_BAR_WORDS * 4);
  p.rs1 = (float*)take((size_t)MT * 4);
  p.ss2 = (float*)take((size_t)MT * 4);
  p.ss3 = (float*)take((size_t)MT * 4);
  char* preg = take((size_t)MT * PW * 2);
  p.proj = (u16*)preg;
  p.act = (u16*)preg;
  p.Vt = (u16*)take((size_t)NB * 512 * LL * 2);
  char* xreg = ws + off;
  p.hb = (u16*)xreg;
  {
    size_t o2 = 0;
    auto tk = [&](size_t bytes) { char* r = xreg + o2; o2 += al256(bytes); return r; };
    const size_t NCK = (size_t)NB * 4 * NCH;
    p.qn = (u16*)tk(NCK * 8192 * 2);
    p.knT = (u16*)tk(NCK * 8192 * 2);
    p.uT = (u16*)tk(2 * NCK * 8192 * 2);
    p.wS = (u16*)tk(2 * NCK * 8192 * 2);
    p.qkS = (u16*)tk(2 * NCK * 4096 * 2);
    p.egS = (float*)tk(2 * NCK * 64 * 4);
    p.ekS = (float*)tk(2 * NCK * 64 * 4);
    p.cdS = (float*)tk(2 * NCK * 4);
    if (off + o2 > ws_size) fprintf(stderr, "mega: workspace too small: need %zu have %zu\n", off + o2, ws_size);
  }
  p.h1 = (float*)xreg;
  p.h2b = (u16*)xreg;
  p.h1b = (u16*)(xreg + al256((size_t)MC * DM * 4));
  p.phase_lo = 0; p.phase_hi = 9;
  void* args[] = {&p};
  hipError_t e = hipLaunchCooperativeKernel((const void*)mega, dim3(grid_blocks), dim3(NTHR), args, LDS_BYTES + 16, stream);
  if (e != hipSuccess) fprintf(stderr, "cooperative launch failed: %s (grid %d)\n", hipGetErrorString(e), grid_blocks);
}
```

```cpp
#include <hip/hip_runtime.h>
#include <hip/hip_bf16.h>
#include <hip/hip_cooperative_groups.h>
#include <cstdio>
namespace cg = cooperative_groups;

typedef unsigned short u16;
using bf16x8 = __attribute__((ext_vector_type(8))) short;
using s16x4 = __attribute__((ext_vector_type(4))) short;
using f32x4 = __attribute__((ext_vector_type(4))) float;

constexpr int DM = 1024, NB = 8, SEQ = 8192, NMETA = 16, LL = SEQ + NMETA, MT = NB * LL;
constexpr int INW = 3600, INP = 3840, PW = 3136;
constexpr int MC = NB * SEQ;
constexpr int DFF = 2816;
constexpr int NCH = 129;
constexpr int NTHR = 512;
constexpr int HLDS = 77824;
constexpr int LDS_BYTES = 2 * HLDS;
constexpr float EPSF = 1e-6f;

constexpr int PC_NAQ = 0, PC_Z = 512, PC_NAK = 1024, PC_DNQ = 1536, PC_DNK = 2048, PC_DNV = 2560, PC_B = 3072, PC_A = 3080;

struct Params {
  const float *x, *meta, *g_mix, *w_in, *rel_bias, *conv_w, *a_log, *dt_bias, *norm_g, *w_out, *g_ffn, *w_gate, *w_up, *w_down, *g_final;
  float* out;
  u16 *WinT, *WoutT, *WguT, *WdT;
  float *rs1, *ss2, *ss3;
  u16* hb;
  u16* proj;
  u16* Vt;
  u16 *qn, *knT, *uT, *wS, *qkS;
  float *egS, *ekS, *cdS;
  float* h1;
  u16* h2b;
  u16* h1b;
  u16* act;
  unsigned* bar;
  int phase_lo, phase_hi;
};

__device__ __forceinline__ float bf2f(u16 h) { return __uint_as_float(((unsigned)h) << 16); }
typedef __bf16 bf16x2_t __attribute__((ext_vector_type(2)));
typedef float f32x2_t __attribute__((ext_vector_type(2)));
__device__ __forceinline__ unsigned pack2(float a, float b) { f32x2_t v = {a, b}; bf16x2_t r = __builtin_convertvector(v, bf16x2_t); return __builtin_bit_cast(unsigned, r); }
__device__ __forceinline__ u16 f2bf(float f) { return (u16)(pack2(f, 0.f) & 0xffffu); }
__device__ __forceinline__ uint2 pack4(f32x4 v) { return make_uint2(pack2(v[0], v[1]), pack2(v[2], v[3])); }
__device__ __forceinline__ bf16x8 pack8(f32x4 a, f32x4 b) {
  union { bf16x8 v; unsigned u[4]; } r;
  r.u[0] = pack2(a[0], a[1]); r.u[1] = pack2(a[2], a[3]); r.u[2] = pack2(b[0], b[1]); r.u[3] = pack2(b[2], b[3]);
  return r.v;
}
__device__ __forceinline__ bf16x8 ld8(const u16* p) { return *reinterpret_cast<const bf16x8*>(p); }
__device__ __forceinline__ bf16x8 ld4x2(const u16* p0, const u16* p1) {
  union { bf16x8 v; uint2 u[2]; } r;
  r.u[0] = *reinterpret_cast<const uint2*>(p0);
  r.u[1] = *reinterpret_cast<const uint2*>(p1);
  return r.v;
}
__device__ __forceinline__ f32x4 mfma16(bf16x8 a, bf16x8 b, f32x4 c) { return __builtin_amdgcn_mfma_f32_16x16x32_bf16(a, b, c, 0, 0, 0); }
__device__ __forceinline__ int sigma(int c) { return (c & ~31) | (((c >> 2) & 3) << 3) | (((c >> 4) & 1) << 2) | (c & 3); }

__device__ void wprep_tile(const Params& p, int item, char* smem, const int tid) {
  float* tl = (float*)smem;
  int type, tr, tk;
  if (item < 960) { type = 0; tr = item / 16; tk = item % 16; }
  else if (item < 1216) { item -= 960; type = 1; tr = item / 16; tk = item % 16; }
  else if (item < 2624) { item -= 1216; type = 2; tr = item / 16; tk = item % 16; }
  else { item -= 2624; type = 3; tr = item / 44; tk = item % 44; }
  int r0 = tr * 64 + (tid & 15) * 4;
  const float* src; int sstride; bool valid = true; const float* gain = nullptr; u16* dst; int kd = 1024;
  if (type == 0) { src = p.w_in + r0; sstride = INW; valid = r0 < INW; gain = p.g_mix; dst = p.WinT; }
  else if (type == 1) { src = p.w_out + r0; sstride = 1024; dst = p.WoutT; }
  else if (type == 2) { int grp = r0 >> 8, wi = r0 & 255; int ff = grp * 128 + (wi & 127); src = (wi < 128 ? p.w_gate : p.w_up) + ff; sstride = DFF; gain = p.g_ffn; dst = p.WguT; }
  else { src = p.w_down + r0; sstride = 1024; dst = p.WdT; kd = DFF; }
  __syncthreads();
#pragma unroll
  for (int i = 0; i < 4; ++i) {
    int kk = (tid >> 4) + 16 * i;
    int k = tk * 64 + kk;
    float4 v = make_float4(0.f, 0.f, 0.f, 0.f);
    if (valid) v = *reinterpret_cast<const float4*>(src + (size_t)k * sstride);
    float g = gain ? gain[k] : 1.f;
    int nn = (tid & 15) * 4;
    tl[(nn + 0) * 65 + kk] = v.x * g; tl[(nn + 1) * 65 + kk] = v.y * g; tl[(nn + 2) * 65 + kk] = v.z * g; tl[(nn + 3) * 65 + kk] = v.w * g;
  }
  __syncthreads();
  int n = tid >> 2, ks = (tid & 3) * 16;
  unsigned o[8];
#pragma unroll
  for (int e = 0; e < 8; ++e) o[e] = pack2(tl[n * 65 + ks + 2 * e], tl[n * 65 + ks + 2 * e + 1]);
  u16* d = dst + (size_t)(tr * 64 + n) * kd + tk * 64 + ks;
  *reinterpret_cast<uint4*>(d) = make_uint4(o[0], o[1], o[2], o[3]);
  *reinterpret_cast<uint4*>(d + 8) = make_uint4(o[4], o[5], o[6], o[7]);
}

__device__ void phase0(const Params& p, char* smem) {
  const int NW = 3328;
  const int half = threadIdx.x >> 8, tid = threadIdx.x & 255;
  for (int it = blockIdx.x * 2 + half; it < NW; it += gridDim.x * 2) wprep_tile(p, it, smem + half * HLDS, tid);
  int lane = threadIdx.x & 63, wv = threadIdx.x >> 6;
  for (int row0 = (blockIdx.x * 8 + wv) * 2; row0 < MC + NMETA; row0 += gridDim.x * 16) {
    float4 v[2][4];
#pragma unroll
    for (int r = 0; r < 2; ++r) {
      const int row = row0 + r;
      const float* src = (row < MC) ? (p.x + (size_t)row * DM) : (p.meta + (size_t)(row - MC) * DM);
#pragma unroll
      for (int i = 0; i < 4; ++i) v[r][i] = *reinterpret_cast<const float4*>(src + i * 256 + lane * 4);
    }
#pragma unroll
    for (int r = 0; r < 2; ++r) {
      const int row = row0 + r;
      float ss = 0.f;
#pragma unroll
      for (int i = 0; i < 4; ++i) {
        const float4 w = v[r][i];
        ss += w.x * w.x + w.y * w.y + w.z * w.z + w.w * w.w;
      }
#pragma unroll
      for (int o = 32; o >= 1; o >>= 1) ss += __shfl_xor(ss, o);
      const float rs = rsqrtf(ss * (1.f / DM) + EPSF);
#pragma unroll
      for (int i = 0; i < 4; ++i) {
        const float4 w = v[r][i];
        *reinterpret_cast<uint2*>(p.hb + (size_t)row * DM + i * 256 + lane * 4) = make_uint2(pack2(w.x * rs, w.y * rs), pack2(w.z * rs, w.w * rs));
      }
      if (lane == 0 && row < MC) { p.ss2[row] = 0.f; p.ss3[row] = 0.f; }
    }
  }
}

#define LAS __attribute__((address_space(3)))
constexpr int BM = 256, BK = 64, HALF = 128, HTB = HALF * BK * 2, STAGE_BYTES = 8 * HTB, NXCD = 8, WGM = 4;
__device__ __forceinline__ int lds_byte(int r, int c) { const int st = (r >> 4) * 2 + (c >> 5), rr = r & 15, cc = c & 31, ob = rr * 64 + cc * 2; return st * 1024 + (ob ^ (((ob >> 9) & 1) << 5)); }
__device__ __forceinline__ void stage_rc(int b, int& R, int& C) { const int st = b / 1024, sb = b % 1024, swz = sb ^ (((sb >> 9) & 1) << 5); R = (st >> 1) * 16 + swz / 64; C = (st & 1) * 32 + (swz % 64) / 2; }
__device__ __forceinline__ int perm32(int rho) { const int n = rho >> 4, i = rho & 15; return 8 * (i >> 2) + 4 * n + (i & 3); }
struct Unit { int pm, pn; };
struct StaticOrder {
  int nM, nN, nwg, G, c;
  __device__ void init(int nM_, int nN_, int G_, int c_) { nM = nM_; nN = nN_; nwg = nM * nN; G = G_; c = c_; }
  __device__ bool next(int i, Unit& u) const {
    const long L = (long)i * G + c; if (L >= nwg) return false;
    int wgid = (int)L; { const int q = nwg / NXCD, r = nwg % NXCD, xcd = wgid % NXCD, off = wgid / NXCD; wgid = (xcd < r ? xcd * (q + 1) : r * (q + 1) + (xcd - r) * q) + off; }
    const int nig = WGM * nN, gid = wgid / nig, fm = gid * WGM, gsz = (nM - fm) < WGM ? (nM - fm) : WGM;
    u.pm = fm + ((wgid % nig) % gsz); u.pn = (wgid % nig) / gsz; return true;
  }
};

__device__ __forceinline__ int proj_col(int c) {
  if (c < 512) return PC_NAQ + c;
  if (c < 1024) return PC_NAK + (c - 512);
  if (c < 1536) return -1;
  if (c < 2048) return PC_DNQ + (c - 1536);
  if (c < 2560) return PC_DNK + (c - 2048);
  if (c < 3072) return PC_DNV + (c - 2560);
  if (c < 3584) return PC_Z + (c - 3072);
  if (c < 3592) return PC_B + (c - 3584);
  if (c < 3600) return PC_A + (c - 3592);
  return -2;
}

template <int EPI>
__device__ __forceinline__ void gemm_epi(const Params& p, const f32x4 (&acc)[2][2][4][2], const Unit& u, int wr, int wc, int fr, int fq) {
  const int mc0 = u.pm * BM + wr * 64 + fr;
  if constexpr (EPI == 1 || EPI == 4) {
    float rsv[2][4];
#pragma unroll
    for (int ai = 0; ai < 2; ++ai)
#pragma unroll
      for (int m = 0; m < 4; ++m) {
        const int mc = mc0 + ai * HALF + m * 16;
        rsv[ai][m] = (EPI == 1) ? 1.f : p.ss2[mc];
      }
#pragma unroll
    for (int ai = 0; ai < 2; ++ai)
#pragma unroll
      for (int m = 0; m < 4; ++m) {
        const int mc = mc0 + ai * HALF + m * 16;
        if constexpr (EPI == 1) {
          const int b = mc >> 13, t = NMETA + (mc & 8191);
          const size_t mf = (size_t)b * LL + t;
#pragma unroll
          for (int bj = 0; bj < 2; ++bj) {
            const int c8 = u.pn * BM + bj * HALF + wc * 32 + fq * 8;
            const int col = proj_col(c8);
            f32x4 v0 = acc[ai][bj][m][0], v1 = acc[ai][bj][m][1];
            if (c8 < 512) { v0 = v0 * 0.125f; v1 = v1 * 0.125f; }
            if (col >= 0) {
              *reinterpret_cast<uint4*>(p.proj + mf * PW + col) = make_uint4(pack2(v0[0], v0[1]), pack2(v0[2], v0[3]), pack2(v1[0], v1[1]), pack2(v1[2], v1[3]));
            } else if (col == -1) {
              u16* vp = p.Vt + ((size_t)(b * 512 + c8 - 1024)) * LL + t;
#pragma unroll
              for (int j = 0; j < 4; ++j) { vp[(size_t)j * LL] = f2bf(v0[j]); vp[(size_t)(4 + j) * LL] = f2bf(v1[j]); }
            }
          }
        } else {
          const float r2 = rsqrtf(rsv[ai][m] * (1.f / DM) + EPSF);
          const int ff8 = u.pn * HALF + wc * 32 + fq * 8;
          float a[8];
#pragma unroll
          for (int n = 0; n < 2; ++n)
#pragma unroll
            for (int j = 0; j < 4; ++j) {
              const float g = acc[ai][0][m][n][j] * r2, uu = acc[ai][1][m][n][j] * r2;
              a[n * 4 + j] = g * __builtin_amdgcn_rcpf(1.f + __expf(-g)) * uu;
            }
          *reinterpret_cast<uint4*>(p.act + (size_t)mc * DFF + ff8) = make_uint4(pack2(a[0], a[1]), pack2(a[2], a[3]), pack2(a[4], a[5]), pack2(a[6], a[7]));
        }
      }
  } else {
    const int c80 = u.pn * BM + wc * 32 + fq * 8;
#pragma unroll
    for (int ai = 0; ai < 2; ++ai) {
      float4 rx[4][2][2];
      uint4 rh[4][2];
#pragma unroll
      for (int m = 0; m < 4; ++m) {
        const int mc = mc0 + ai * HALF + m * 16;
#pragma unroll
        for (int bj = 0; bj < 2; ++bj) {
          if constexpr (EPI == 3) {
            const float* res = p.x + (size_t)mc * DM + c80 + bj * HALF;
            rx[m][bj][0] = *reinterpret_cast<const float4*>(res); rx[m][bj][1] = *reinterpret_cast<const float4*>(res + 4);
          } else {
            rh[m][bj] = *reinterpret_cast<const uint4*>(p.h1b + (size_t)mc * DM + c80 + bj * HALF);
          }
        }
      }
#pragma unroll
      for (int m = 0; m < 4; ++m) {
        const int mc = mc0 + ai * HALF + m * 16;
        float ss = 0.f;
#pragma unroll
        for (int bj = 0; bj < 2; ++bj) {
          const int c8 = c80 + bj * HALF;
          f32x4 v0 = acc[ai][bj][m][0], v1 = acc[ai][bj][m][1];
          if constexpr (EPI == 3) {
            const float4 r0 = rx[m][bj][0], r1 = rx[m][bj][1];
            v0[0] += r0.x; v0[1] += r0.y; v0[2] += r0.z; v0[3] += r0.w;
            v1[0] += r1.x; v1[1] += r1.y; v1[2] += r1.z; v1[3] += r1.w;
            *reinterpret_cast<uint4*>(p.h1b + (size_t)mc * DM + c8) = make_uint4(pack2(v0[0], v0[1]), pack2(v0[2], v0[3]), pack2(v1[0], v1[1]), pack2(v1[2], v1[3]));
          } else {
            const uint4 rb = rh[m][bj];
            v0[0] += __uint_as_float(rb.x << 16); v0[1] += __uint_as_float(rb.x & 0xffff0000u);
            v0[2] += __uint_as_float(rb.y << 16); v0[3] += __uint_as_float(rb.y & 0xffff0000u);
            v1[0] += __uint_as_float(rb.z << 16); v1[1] += __uint_as_float(rb.z & 0xffff0000u);
            v1[2] += __uint_as_float(rb.w << 16); v1[3] += __uint_as_float(rb.w & 0xffff0000u);
            *reinterpret_cast<uint4*>(p.h2b + (size_t)mc * DM + c8) = make_uint4(pack2(v0[0], v0[1]), pack2(v0[2], v0[3]), pack2(v1[0], v1[1]), pack2(v1[2], v1[3]));
          }
#pragma unroll
          for (int j = 0; j < 4; ++j) ss += v0[j] * v0[j] + v1[j] * v1[j];
        }
        ss += __shfl_xor(ss, 16); ss += __shfl_xor(ss, 32);
        if (fq == 0) atomicAdd(((EPI == 3) ? p.ss2 : p.ss3) + mc, ss);
      }
    }
  }
}

template <int EPI, bool ROWMAP>
__device__ __forceinline__ void gemm_phase(const Params& p, LAS unsigned char* lds, const u16* A, const int lda, const u16* Bt, const int nN, const int K) {
  const int tid = threadIdx.x, wid = __builtin_amdgcn_readfirstlane(tid >> 6), lane = tid & 63, wr = wid >> 2, wc = wid & 3, fr = lane & 15, fq = lane >> 4;
  const int nt = K / BK;
  StaticOrder S; S.init(MC / BM, nN, gridDim.x, blockIdx.x);
  unsigned voffA[2], voffB[2];
#pragma unroll
  for (int i = 0; i < 2; ++i) { int R, C; stage_rc(tid * 16 + i * 8192, R, C); const int Rb = (R & ~31) + perm32(R & 31);
    voffA[i] = (unsigned)(R * lda + C) * 2u; voffB[i] = (unsigned)(Rb * K + C) * 2u; }
  const size_t kstep = (size_t)(BK * 2);
  const size_t hstepA = (size_t)HALF * lda * 2, hstepB = (size_t)HALF * K * 2;
  const unsigned ldsw = (unsigned)wid * 1024u;
  const int aoff = lds_byte(wr * 64 + fr, fq * 8), boff = lds_byte(wc * 32 + fr, fq * 8);
#define PG8_ABASE(pm_) ((const char*)A + (size_t)(ROWMAP ? (((pm_) >> 5) * LL + NMETA + ((pm_) & 31) * BM) : (pm_) * BM) * lda * 2)
#define PG8_BBASE(pn_) ((const char*)Bt + (size_t)(pn_) * 2 * hstepB)
#define PG8_SA(b, h) (((b) * 2 + (h)) * HTB)
#define PG8_SB(b, h) ((4 + (b) * 2 + (h)) * HTB)
#define PG8_STAGE(bufoff, gbase, voff) do { _Pragma("unroll") for (int _i = 0; _i < 2; ++_i) \
    __builtin_amdgcn_global_load_lds((const unsigned*)((const char*)(gbase) + (voff)[_i]), (LAS unsigned*)(lds + (bufoff) + ldsw + _i * 8192), 16, 0, 0); } while (0)
#define PG8_LDA(dst, b, h) do { _Pragma("unroll") for (int m = 0; m < 4; ++m) _Pragma("unroll") for (int k = 0; k < 2; ++k) dst[m][k] = *(const LAS bf16x8*)(lds + PG8_SA(b, h) + aoff + m * 2048 + k * 1024); } while (0)
#define PG8_LDB(dst, b, h) do { _Pragma("unroll") for (int n = 0; n < 2; ++n) _Pragma("unroll") for (int k = 0; k < 2; ++k) dst[n][k] = *(const LAS bf16x8*)(lds + PG8_SB(b, h) + boff + n * 2048 + k * 1024); } while (0)
#define PG8_MMA(ai, bj, At, Bt_) do { __builtin_amdgcn_s_setprio(1); _Pragma("unroll") for (int m = 0; m < 4; ++m) _Pragma("unroll") for (int n = 0; n < 2; ++n) _Pragma("unroll") for (int k = 0; k < 2; ++k) \
    acc[ai][bj][m][n] = __builtin_amdgcn_mfma_f32_16x16x32_bf16(Bt_[n][k], At[m][k], acc[ai][bj][m][n], 0, 0, 0); __builtin_amdgcn_s_setprio(0); } while (0)
#define PG8_WAIT_V(n) asm volatile("s_waitcnt vmcnt(" #n ")" ::: "memory")
#define PG8_WAIT_L(n) asm volatile("s_waitcnt lgkmcnt(" #n ")" ::: "memory")
#define PG8_BAR __builtin_amdgcn_s_barrier()
#define PG8_SCHED __builtin_amdgcn_sched_barrier(0)
  Unit cur, nxt; int ui = 0;
  if (!S.next(0, cur)) return;
  f32x4 acc[2][2][4][2];
#pragma unroll
  for (int a = 0; a < 2; ++a)
#pragma unroll
    for (int b = 0; b < 2; ++b)
#pragma unroll
      for (int m = 0; m < 4; ++m)
#pragma unroll
        for (int n = 0; n < 2; ++n) acc[a][b][m][n] = f32x4{0.f, 0.f, 0.f, 0.f};
  bf16x8 At[4][2], B0[2][2], B1[2][2];
  const char* cA = PG8_ABASE(cur.pm); const char* cB = PG8_BBASE(cur.pn);
  PG8_STAGE(PG8_SB(0, 0), cB, voffB); PG8_STAGE(PG8_SA(0, 0), cA, voffA); PG8_STAGE(PG8_SB(0, 1), cB + hstepB, voffB); PG8_STAGE(PG8_SA(0, 1), cA + hstepA, voffA);
  if (wr == 1) PG8_BAR;
  PG8_WAIT_V(4); PG8_BAR;
  PG8_STAGE(PG8_SB(1, 0), cB + kstep, voffB); PG8_STAGE(PG8_SA(1, 0), cA + kstep, voffA); PG8_STAGE(PG8_SB(1, 1), cB + hstepB + kstep, voffB);
  PG8_WAIT_V(6); PG8_BAR;
  for (;;) {
    const bool has_next = S.next(ui + 1, nxt);
    const char* nA = has_next ? PG8_ABASE(nxt.pm) : cA; const char* nB = has_next ? PG8_BBASE(nxt.pn) : cB;
    for (int t = 0; t < nt; t += 2) {
      const bool last = (t == nt - 2);
      const char* a1 = cA + (size_t)(t + 1) * kstep;
      const char* a2 = last ? nA : cA + (size_t)(t + 2) * kstep; const char* b2 = last ? nB : cB + (size_t)(t + 2) * kstep;
      const char* a3 = a2 + kstep; const char* b3 = b2 + kstep;
      PG8_LDB(B0, 0, 0); PG8_SCHED; PG8_LDA(At, 0, 0); PG8_STAGE(PG8_SA(1, 1), a1 + hstepA, voffA);
      PG8_WAIT_L(8); PG8_BAR; PG8_WAIT_L(0); PG8_MMA(0, 0, At, B0); PG8_BAR; PG8_SCHED;
      PG8_LDB(B1, 0, 1); PG8_STAGE(PG8_SB(0, 0), b2, voffB);
      PG8_BAR; PG8_WAIT_L(0); PG8_MMA(0, 1, At, B1); PG8_BAR;
      PG8_LDA(At, 0, 1); PG8_STAGE(PG8_SA(0, 0), a2, voffA);
      PG8_BAR; PG8_WAIT_L(0); PG8_MMA(1, 0, At, B0); PG8_BAR; PG8_SCHED;
      PG8_STAGE(PG8_SB(0, 1), b2 + hstepB, voffB);
      PG8_WAIT_V(6); PG8_BAR; PG8_MMA(1, 1, At, B1); PG8_BAR;
      PG8_LDB(B0, 1, 0); PG8_SCHED; PG8_LDA(At, 1, 0); PG8_STAGE(PG8_SA(0, 1), a2 + hstepA, voffA);
      PG8_WAIT_L(8); PG8_BAR; PG8_WAIT_L(0); PG8_MMA(0, 0, At, B0); PG8_BAR; PG8_SCHED;
      PG8_LDB(B1, 1, 1); PG8_STAGE(PG8_SB(1, 0), b3, voffB);
      PG8_BAR; PG8_WAIT_L(0); PG8_MMA(0, 1, At, B1); PG8_BAR;
      PG8_LDA(At, 1, 1); PG8_STAGE(PG8_SA(1, 0), a3, voffA);
      PG8_BAR; PG8_WAIT_L(0); PG8_MMA(1, 0, At, B0); PG8_BAR; PG8_SCHED;
      PG8_STAGE(PG8_SB(1, 1), b3 + hstepB, voffB);
      PG8_WAIT_V(6); PG8_BAR; PG8_MMA(1, 1, At, B1); PG8_BAR;
    }
    gemm_epi<EPI>(p, acc, cur, wr, wc, fr, fq);
    if (!has_next) break;
#pragma unroll
    for (int a = 0; a < 2; ++a)
#pragma unroll
      for (int b = 0; b < 2; ++b)
#pragma unroll
        for (int m = 0; m < 4; ++m)
#pragma unroll
          for (int n = 0; n < 2; ++n) acc[a][b][m][n] = f32x4{0.f, 0.f, 0.f, 0.f};
    cur = nxt; cA = nA; cB = nB; ++ui;
  }
  PG8_WAIT_V(0);
  if (wr == 0) PG8_BAR;
  PG8_BAR;
#undef PG8_ABASE
#undef PG8_BBASE
#undef PG8_SA
#undef PG8_SB
#undef PG8_STAGE
#undef PG8_LDA
#undef PG8_LDB
#undef PG8_MMA
}

__device__ void meta_inproj(const Params& p) {
  const int lane = threadIdx.x & 63, l16 = lane & 15, quad = lane >> 4;
  for (int nt = blockIdx.x * 8 + (threadIdx.x >> 6); nt < INW / 16; nt += gridDim.x * 8) {
    f32x4 acc = f32x4{0.f, 0.f, 0.f, 0.f};
    const u16* wrow = p.WinT + (size_t)(nt * 16 + l16) * DM + quad * 8;
    const u16* arow = p.hb + (size_t)(MC + l16) * DM + quad * 8;
#pragma unroll 4
    for (int ks = 0; ks < 32; ++ks) acc = mfma16(ld8(wrow + ks * 32), ld8(arow + ks * 32), acc);
    const int c = nt * 16 + quad * 4;
    f32x4 v = acc;
    if (c < 512) v = v * 0.125f;
    const int col = proj_col(c);
    for (int b = 0; b < NB; ++b) {
      if (col >= 0) *reinterpret_cast<uint2*>(p.proj + ((size_t)b * LL + l16) * PW + col) = pack4(v);
      else if (col == -1) {
#pragma unroll
        for (int j = 0; j < 4; ++j) p.Vt[((size_t)(b * 512 + c - 1024 + j)) * LL + l16] = f2bf(v[j]);
      }
    }
  }
}

template <int NG>
__device__ __forceinline__ void na_wave(const Params& p, int b, int h, int qtok0, int r, int wq, int kr0, int jb0) {
  const int lane = threadIdx.x & 63, l16 = lane & 15, quad = lane >> 4;
  u16* proj = p.proj + (size_t)b * LL * PW;
  const u16* Vt = p.Vt + (size_t)(b * 512 + h * 64) * LL;
  const int qtok = qtok0 + l16;
  bf16x8 qf0 = ld8(proj + (size_t)qtok * PW + PC_NAQ + h * 64 + quad * 8);
  bf16x8 qf1 = ld8(proj + (size_t)qtok * PW + PC_NAQ + h * 64 + 32 + quad * 8);
  constexpr int NTL = NG + 1;
  f32x4 sc[NTL];
  const int qc = wq * 16 + l16;
  const int cs = min(max(qc - 8, 0), 48);
  const float* bias_h = p.rel_bias + h * (15 * 31);
#pragma unroll
  for (int t = 0; t < NG; ++t) {
    const int i = t / 3, jj = t % 3;
    const int ktok = NMETA + (kr0 + i) * 64 + (jb0 + jj) * 16 + l16;
    const u16* kp = proj + (size_t)ktok * PW + PC_NAK + h * 64 + quad * 8;
    f32x4 a = f32x4{0.f, 0.f, 0.f, 0.f};
    a = mfma16(ld8(kp), qf0, a);
    a = mfma16(ld8(kp + 32), qf1, a);
    const float* brow = bias_h + (kr0 + i - r + 7) * 31;
#pragma unroll
    for (int j = 0; j < 4; ++j) {
      const int kc = (jb0 + jj) * 16 + quad * 4 + j;
      const int dc = min(max(kc - qc, -15), 15) + 15;
      const bool in = (kc >= cs) && (kc < cs + 16);
      a[j] = in ? (a[j] + brow[dc]) : -1e30f;
    }
    sc[t] = a;
    if (t % 3 == 2) asm volatile("" ::: "memory");
  }
  {
    const u16* kp = proj + (size_t)l16 * PW + PC_NAK + h * 64 + quad * 8;
    f32x4 a = f32x4{0.f, 0.f, 0.f, 0.f};
    a = mfma16(ld8(kp), qf0, a);
    a = mfma16(ld8(kp + 32), qf1, a);
    sc[NG] = a;
  }
  float mx = -1e30f;
#pragma unroll
  for (int t = 0; t < NTL; ++t)
#pragma unroll
    for (int j = 0; j < 4; ++j) mx = fmaxf(mx, sc[t][j]);
  mx = fmaxf(mx, __shfl_xor(mx, 16));
  mx = fmaxf(mx, __shfl_xor(mx, 32));
  float sum = 0.f;
#pragma unroll
  for (int t = 0; t < NTL; ++t)
#pragma unroll
    for (int j = 0; j < 4; ++j) { float e = __expf(sc[t][j] - mx); sc[t][j] = e; sum += e; }
  sum += __shfl_xor(sum, 16);
  sum += __shfl_xor(sum, 32);
  const float inv = 1.f / sum;
  f32x4 o[4];
#pragma unroll
  for (int d = 0; d < 4; ++d) o[d] = f32x4{0.f, 0.f, 0.f, 0.f};
#pragma unroll
  for (int pr = 0; pr < NG / 2; ++pr) {
    const int t0 = 2 * pr, t1 = 2 * pr + 1;
    const int tok0 = NMETA + (kr0 + t0 / 3) * 64 + (jb0 + t0 % 3) * 16 + quad * 4;
    const int tok1 = NMETA + (kr0 + t1 / 3) * 64 + (jb0 + t1 % 3) * 16 + quad * 4;
    bf16x8 pf = pack8(sc[t0], sc[t1]);
#pragma unroll
    for (int d = 0; d < 4; ++d) {
      const u16* vr = Vt + (size_t)(d * 16 + l16) * LL;
      o[d] = mfma16(ld4x2(vr + tok0, vr + tok1), pf, o[d]);
    }
    if (pr & 1) asm volatile("" ::: "memory");
  }
  {
    f32x4 z = f32x4{0.f, 0.f, 0.f, 0.f};
    bf16x8 pf = pack8(sc[NG], z);
#pragma unroll
    for (int d = 0; d < 4; ++d) {
      const u16* vr = Vt + (size_t)(d * 16 + l16) * LL;
      union { bf16x8 v; uint2 u[2]; } vf;
      vf.u[0] = *reinterpret_cast<const uint2*>(vr + quad * 4);
      vf.u[1] = make_uint2(0u, 0u);
      o[d] = mfma16(vf.v, pf, o[d]);
    }
  }
#pragma unroll
  for (int d = 0; d < 4; ++d) {
    f32x4 v = o[d] * inv;
    *reinterpret_cast<uint2*>(proj + (size_t)qtok * PW + PC_NAQ + h * 64 + d * 16 + quad * 4) = pack4(v);
  }
}

__device__ void na_item(const Params& p, int item) {
  const int wv = (threadIdx.x >> 6) & 3;
  if (item < 8192) {
    const int h = item & 7, r = (item >> 3) & 127, b = item >> 10;
    const int kr0 = min(max(r - 4, 0), 120);
    const int jb0 = min(max(wv - 1, 0), 1);
    na_wave<24>(p, b, h, NMETA + r * 64 + wv * 16, r, wv, kr0, jb0);
  } else {
    item -= 8192;
    if (wv == 0) na_wave<0>(p, item >> 3, item & 7, 0, 0, 0, 0, 0);
  }
}

__device__ __forceinline__ f32x4 na_tile(const int t, const u16* KL, const int jb0, const int l16, const int quad, const bf16x8 qf0, const bf16x8 qf1,
                                         const float* bias_h, const int dr0, const int qc, const int cs) {
  const int i = t / 3, jj = t % 3;
  const u16* kp = KL + (i * 64 + (jb0 + jj) * 16 + l16) * 72 + quad * 8;
  f32x4 a = f32x4{0.f, 0.f, 0.f, 0.f};
  a = mfma16(ld8(kp), qf0, a);
  a = mfma16(ld8(kp + 32), qf1, a);
  const float* brow = bias_h + (dr0 + i) * 31;
#pragma unroll
  for (int j = 0; j < 4; ++j) {
    const int kc = (jb0 + jj) * 16 + quad * 4 + j;
    const int dc = min(max(kc - qc, -15), 15) + 15;
    const bool in = (kc >= cs) && (kc < cs + 16);
    a[j] = in ? (a[j] + brow[dc]) : -1e30f;
  }
  return a;
}
constexpr int NA_VS = 536;
__device__ void na_items(const Params& p, char* hsm, const int tid_in, const int first_item, const int stride) {
  int tid = tid_in;
  asm volatile("" : "+v"(tid));
  const int lane = tid & 63, wv = tid >> 6, l16 = lane & 15, quad = lane >> 4;
  u16* KL = (u16*)hsm;
  u16* VT = (u16*)hsm;
  uint4 k0, k1, k2, k3, k4, k5, k6, k7, k8, k9, k10, k11, k12, k13, k14, k15, km;
  bf16x8 qf0, qf1;
  float kbias;
  const int jb0 = min(max(wv - 1, 0), 1);
  const int qc = wv * 16 + l16;
  const int cs = min(max(qc - 8, 0), 48);
  float* BL = (float*)(hsm + 76032);
  const int brow_ = min(tid / 31, 7), bcol_ = tid % 31;
#define NA_KLOAD(item_)                                                                                              \
  {                                                                                                                  \
    const int h_ = (item_) & 7, r_ = ((item_) >> 3) & 127, b_ = (item_) >> 10;                                        \
    const int kr0_ = min(max(r_ - 4, 0), 120);                                                                       \
    const u16* pb_ = p.proj + (size_t)b_ * LL * PW;                                                                  \
    const u16* kp_ = pb_ + (size_t)(NMETA + kr0_ * 64 + (tid >> 3)) * PW + PC_NAK + h_ * 64 + (tid & 7) * 8;         \
    k0 = *reinterpret_cast<const uint4*>(kp_); k1 = *reinterpret_cast<const uint4*>(kp_ + (size_t)32 * PW);         \
    k2 = *reinterpret_cast<const uint4*>(kp_ + (size_t)64 * PW); k3 = *reinterpret_cast<const uint4*>(kp_ + (size_t)96 * PW);   \
    k4 = *reinterpret_cast<const uint4*>(kp_ + (size_t)128 * PW); k5 = *reinterpret_cast<const uint4*>(kp_ + (size_t)160 * PW); \
    k6 = *reinterpret_cast<const uint4*>(kp_ + (size_t)192 * PW); k7 = *reinterpret_cast<const uint4*>(kp_ + (size_t)224 * PW); \
    k8 = *reinterpret_cast<const uint4*>(kp_ + (size_t)256 * PW); k9 = *reinterpret_cast<const uint4*>(kp_ + (size_t)288 * PW); \
    k10 = *reinterpret_cast<const uint4*>(kp_ + (size_t)320 * PW); k11 = *reinterpret_cast<const uint4*>(kp_ + (size_t)352 * PW); \
    k12 = *reinterpret_cast<const uint4*>(kp_ + (size_t)384 * PW); k13 = *reinterpret_cast<const uint4*>(kp_ + (size_t)416 * PW); \
    k14 = *reinterpret_cast<const uint4*>(kp_ + (size_t)448 * PW); k15 = *reinterpret_cast<const uint4*>(kp_ + (size_t)480 * PW); \
    km = *reinterpret_cast<const uint4*>(pb_ + (size_t)((tid >> 3) & 15) * PW + PC_NAK + h_ * 64 + (tid & 7) * 8);    \
    const u16* qp_ = pb_ + (size_t)(NMETA + r_ * 64 + wv * 16 + l16) * PW + PC_NAQ + h_ * 64 + quad * 8;            \
    qf0 = ld8(qp_); qf1 = ld8(qp_ + 32);                                                                             \
    kbias = p.rel_bias[h_ * 465 + (kr0_ - r_ + 7 + brow_) * 31 + bcol_];                                            \
  }
  int item = first_item;
  { const int it0 = item < 8192 ? item : 0; NA_KLOAD(it0); }
  for (; item < 8192; item += stride) {
    const int h = item & 7, r = (item >> 3) & 127, b = item >> 10;
    const int kr0 = min(max(r - 4, 0), 120);
    u16* proj = p.proj + (size_t)b * LL * PW;
    __syncthreads();
    {
      u16* kd = KL + (tid >> 3) * 64 + (((tid & 7) ^ ((tid >> 3) & 7)) * 8);
      *reinterpret_cast<uint4*>(kd) = k0; *reinterpret_cast<uint4*>(kd + 32 * 64) = k1; *reinterpret_cast<uint4*>(kd + 64 * 64) = k2;
      *reinterpret_cast<uint4*>(kd + 96 * 64) = k3; *reinterpret_cast<uint4*>(kd + 128 * 64) = k4; *reinterpret_cast<uint4*>(kd + 160 * 64) = k5;
      *reinterpret_cast<uint4*>(kd + 192 * 64) = k6; *reinterpret_cast<uint4*>(kd + 224 * 64) = k7; *reinterpret_cast<uint4*>(kd + 256 * 64) = k8;
      *reinterpret_cast<uint4*>(kd + 288 * 64) = k9; *reinterpret_cast<uint4*>(kd + 320 * 64) = k10; *reinterpret_cast<uint4*>(kd + 352 * 64) = k11;
      *reinterpret_cast<uint4*>(kd + 384 * 64) = k12; *reinterpret_cast<uint4*>(kd + 416 * 64) = k13; *reinterpret_cast<uint4*>(kd + 448 * 64) = k14;
      *reinterpret_cast<uint4*>(kd + 480 * 64) = k15;
      if (tid < 128) *reinterpret_cast<uint4*>(kd + 512 * 64) = km;
      if (tid < 248) BL[brow_ * 32 + bcol_] = kbias;
    }
    __syncthreads();
    uint4 v0, v1, v2, v3, vm;
    const u16* vb = p.Vt + (size_t)(b * 512 + h * 64) * LL;
    const u16* vp = vb + (size_t)(tid >> 6) * LL + NMETA + kr0 * 64 + (tid & 63) * 8;
    {
      v0 = *reinterpret_cast<const uint4*>(vp); v1 = *reinterpret_cast<const uint4*>(vp + (size_t)4 * LL);
      v2 = *reinterpret_cast<const uint4*>(vp + (size_t)8 * LL); v3 = *reinterpret_cast<const uint4*>(vp + (size_t)12 * LL);
      vm = *reinterpret_cast<const uint4*>(vb + (size_t)((tid >> 1) & 63) * LL + (tid & 1) * 8);
    }
    f32x4 sc[25];
    {
      int dco[12]; bool inm[12];
#pragma unroll
      for (int jj = 0; jj < 3; ++jj)
#pragma unroll
        for (int j = 0; j < 4; ++j) {
          const int kc = (jb0 + jj) * 16 + quad * 4 + j;
          dco[jj * 4 + j] = min(max(kc - qc, -15), 15) + 15;
          inm[jj * 4 + j] = (kc >= cs) && (kc < cs + 16);
        }
      const u16* kbase = KL + (jb0 * 16 + l16) * 64;
      const int ko0 = ((quad ^ (l16 & 7)) * 8), ko1 = (((4 + quad) ^ (l16 & 7)) * 8);
#pragma unroll
      for (int i = 0; i < 8; ++i) {
#pragma unroll
        for (int jj = 0; jj < 3; ++jj) {
          const u16* kp = kbase + (i * 64 + jj * 16) * 64;
          f32x4 a = f32x4{0.f, 0.f, 0.f, 0.f};
          a = mfma16(ld8(kp + ko0), qf0, a);
          a = mfma16(ld8(kp + ko1), qf1, a);
#pragma unroll
          for (int j = 0; j < 4; ++j) a[j] = inm[jj * 4 + j] ? (a[j] + BL[i * 32 + dco[jj * 4 + j]]) : -1e30f;
          sc[i * 3 + jj] = a;
        }
        asm volatile("" ::: "memory");
      }
    }
    {
      const u16* kp = KL + (512 + l16) * 64;
      f32x4 a = f32x4{0.f, 0.f, 0.f, 0.f};
      a = mfma16(ld8(kp + ((quad ^ (l16 & 7)) * 8)), qf0, a);
      a = mfma16(ld8(kp + (((4 + quad) ^ (l16 & 7)) * 8)), qf1, a);
      sc[24] = a;
    }
    float mx = -1e30f;
#pragma unroll
    for (int t = 0; t < 25; ++t)
#pragma unroll
      for (int j = 0; j < 4; ++j) mx = fmaxf(mx, sc[t][j]);
    mx = fmaxf(mx, __shfl_xor(mx, 16));
    mx = fmaxf(mx, __shfl_xor(mx, 32));
    float sum = 0.f;
#pragma unroll
    for (int t = 0; t < 25; ++t)
#pragma unroll
      for (int j = 0; j < 4; ++j) { float e = __expf(sc[t][j] - mx); sc[t][j] = e; sum += e; }
    sum += __shfl_xor(sum, 16);
    sum += __shfl_xor(sum, 32);
    const float inv = 1.f / sum;
    bf16x8 pf[13];
#pragma unroll
    for (int pr = 0; pr < 12; ++pr) pf[pr] = pack8(sc[2 * pr], sc[2 * pr + 1]);
    pf[12] = pack8(sc[24], f32x4{0.f, 0.f, 0.f, 0.f});
    asm volatile("" ::: "memory");
    uint4 v4, v5, v6, v7, v8, v9, v10, v11, v12, v13, v14, v15;
    {
      v4 = *reinterpret_cast<const uint4*>(vp + (size_t)16 * LL); v5 = *reinterpret_cast<const uint4*>(vp + (size_t)20 * LL);
      v6 = *reinterpret_cast<const uint4*>(vp + (size_t)24 * LL); v7 = *reinterpret_cast<const uint4*>(vp + (size_t)28 * LL);
      v8 = *reinterpret_cast<const uint4*>(vp + (size_t)32 * LL); v9 = *reinterpret_cast<const uint4*>(vp + (size_t)36 * LL);
      v10 = *reinterpret_cast<const uint4*>(vp + (size_t)40 * LL); v11 = *reinterpret_cast<const uint4*>(vp + (size_t)44 * LL);
      v12 = *reinterpret_cast<const uint4*>(vp + (size_t)48 * LL); v13 = *reinterpret_cast<const uint4*>(vp + (size_t)52 * LL);
      v14 = *reinterpret_cast<const uint4*>(vp + (size_t)56 * LL); v15 = *reinterpret_cast<const uint4*>(vp + (size_t)60 * LL);
    }
    __syncthreads();
    u16* vd = VT + (tid >> 6) * NA_VS + (tid & 63) * 8;
    {
      *reinterpret_cast<uint4*>(vd) = v0; *reinterpret_cast<uint4*>(vd + 4 * NA_VS) = v1; *reinterpret_cast<uint4*>(vd + 8 * NA_VS) = v2;
      *reinterpret_cast<uint4*>(vd + 12 * NA_VS) = v3;
      if (tid < 128) *reinterpret_cast<uint4*>(VT + (tid >> 1) * NA_VS + 512 + (tid & 1) * 8) = vm;
    }
    __syncthreads();
    const int qtok = NMETA + r * 64 + wv * 16 + l16;
    f32x4 o[4];
#pragma unroll
    for (int d = 0; d < 4; ++d) o[d] = f32x4{0.f, 0.f, 0.f, 0.f};
#define NA_PV(d_lo, d_hi)                                                                       \
    {                                                                                           \
      _Pragma("unroll") for (int pr = 0; pr < 12; ++pr) {                                       \
        const int t0 = 2 * pr, t1 = 2 * pr + 1;                                                 \
        const int tokA = (t0 / 3) * 64 + (jb0 + t0 % 3) * 16 + quad * 4;                        \
        const int tokB = (t1 / 3) * 64 + (jb0 + t1 % 3) * 16 + quad * 4;                        \
        _Pragma("unroll") for (int d = d_lo; d < d_hi; ++d) {                                   \
          const u16* vr = VT + (d * 16 + l16) * NA_VS;                                          \
          o[d] = mfma16(ld4x2(vr + tokA, vr + tokB), pf[pr], o[d]);                             \
        }                                                                                       \
        if (pr % 2 == 1) asm volatile("" ::: "memory");                                         \
      }                                                                                         \
      _Pragma("unroll") for (int d = d_lo; d < d_hi; ++d) {                                     \
        const u16* vr = VT + (d * 16 + l16) * NA_VS + 512 + quad * 4;                           \
        union { bf16x8 v; uint2 u[2]; } vf;                                                     \
        vf.u[0] = *reinterpret_cast<const uint2*>(vr);                                          \
        vf.u[1] = make_uint2(0u, 0u);                                                           \
        o[d] = mfma16(vf.v, pf[12], o[d]);                                                      \
      }                                                                                         \
    }
    NA_PV(0, 1);
    {
      *reinterpret_cast<uint4*>(vd + 16 * NA_VS) = v4; *reinterpret_cast<uint4*>(vd + 20 * NA_VS) = v5;
      *reinterpret_cast<uint4*>(vd + 24 * NA_VS) = v6; *reinterpret_cast<uint4*>(vd + 28 * NA_VS) = v7;
      *reinterpret_cast<uint4*>(vd + 32 * NA_VS) = v8; *reinterpret_cast<uint4*>(vd + 36 * NA_VS) = v9; *reinterpret_cast<uint4*>(vd + 40 * NA_VS) = v10;
      *reinterpret_cast<uint4*>(vd + 44 * NA_VS) = v11; *reinterpret_cast<uint4*>(vd + 48 * NA_VS) = v12; *reinterpret_cast<uint4*>(vd + 52 * NA_VS) = v13;
      *reinterpret_cast<uint4*>(vd + 56 * NA_VS) = v14; *reinterpret_cast<uint4*>(vd + 60 * NA_VS) = v15;
    }
    __syncthreads();
    {
      const int nx = (item + stride < 8192) ? (item + stride) : item;
      NA_KLOAD(nx);
    }
    NA_PV(1, 4);
#undef NA_PV
#pragma unroll
    for (int d = 0; d < 4; ++d) {
      f32x4 v = o[d] * inv;
      *reinterpret_cast<uint2*>(proj + (size_t)qtok * PW + PC_NAQ + h * 64 + d * 16 + quad * 4) = pack4(v);
    }
  }
#undef NA_KLOAD
  for (; item < 8192 + 64; item += stride)
    if (wv == 0) na_wave<0>(p, (item - 8192) >> 3, item & 7, 0, 0, 0, 0, 0);
}

__device__ void dn_prep(const Params& p, int item, char* smem, const int tid_in) {
  int tid = tid_in;
  asm volatile("" : "+v"(tid));
  const int h = item & 3, n = (item >> 2) % NCH, b = item / (4 * NCH);
  const int lane = tid & 63, wv = tid >> 6, l16 = lane & 15, quad = lane >> 4;
  u16* qL = (u16*)smem;
  u16* kL = qL + 64 * 136;
  float* G1 = (float*)smem;
  float* G2 = G1 + 64 * 68;
  u16* Tb = (u16*)smem;
  u16* kT = (u16*)(smem + 36864);
  u16* vT = kT + 128 * 72;
  float* vec = (float*)(smem + 36864 + 36864);
  float* gcv = vec;
  float* btv = vec + 128;
  const size_t cidx = (size_t)(b * 4 + h) * NCH + n;
  const size_t dcf = ((size_t)(b * 4 + h) * 2 + 0) * NCH + n;
  const size_t dcb = ((size_t)(b * 4 + h) * 2 + 1) * NCH + n;
  const int tbase = n * 64 - 48;
  __syncthreads();
  if (tid < 128) {
    const int dir = wv, c = lane;
    const int t = tbase + c;
    float beta = 0.f, g = 0.f;
    if (t >= 0) {
      const size_t m = (size_t)b * LL + t;
      float bv = bf2f(p.proj[m * PW + PC_B + dir * 4 + h]);
      float av = bf2f(p.proj[m * PW + PC_A + dir * 4 + h]);
      beta = 1.f / (1.f + expf(-bv));
      float xx = av + p.dt_bias[dir * 4 + h];
      float sp = (xx > 20.f) ? xx : log1pf(expf(xx));
      g = -expf(p.a_log[dir * 4 + h]) * sp;
    }
    float s = g;
    if (dir == 0) {
#pragma unroll
      for (int o = 1; o < 64; o <<= 1) { float y = __shfl_up(s, o); if (lane >= o) s += y; }
    } else {
#pragma unroll
      for (int o = 1; o < 64; o <<= 1) { float y = __shfl_down(s, o); if (lane + o < 64) s += y; }
    }
    gcv[dir * 64 + c] = s;
    btv[dir * 64 + c] = beta;
    const float tot = __shfl(s, dir == 0 ? 63 : 0);
    const size_t dc = dir ? dcb : dcf;
    p.egS[dc * 64 + c] = expf(s);
    p.ekS[dc * 64 + c] = expf(tot - s);
    if (lane == 0) p.cdS[dc] = expf(tot);
  }
  {
    const int cg_ = tid & 15, tg = tid >> 4;
#pragma unroll 1
    for (int pass = 0; pass < 3; ++pass) {
      const int pcol = PC_DNQ + pass * 512 + h * 128 + cg_ * 8;
      const int wcol = pass * 512 + h * 128 + cg_ * 8;
      bf16x8 xr[8];
#pragma unroll
      for (int rr = 0; rr < 8; ++rr) {
        const int t = tbase + tg * 4 - 2 + rr;
        if (t >= 0 && t < LL) xr[rr] = ld8(p.proj + ((size_t)b * LL + t) * PW + pcol);
        else xr[rr] = bf16x8{0, 0, 0, 0, 0, 0, 0, 0};
      }
      float y[4][8];
#pragma unroll
      for (int o = 0; o < 4; ++o)
#pragma unroll
        for (int e = 0; e < 8; ++e) y[o][e] = 0.f;
      float wgt[5][8];
#pragma unroll
      for (int i = 0; i < 5; ++i) {
        float4 w0 = *reinterpret_cast<const float4*>(p.conv_w + (size_t)i * 1536 + wcol);
        float4 w1 = *reinterpret_cast<const float4*>(p.conv_w + (size_t)i * 1536 + wcol + 4);
        wgt[i][0] = w0.x; wgt[i][1] = w0.y; wgt[i][2] = w0.z; wgt[i][3] = w0.w; wgt[i][4] = w1.x; wgt[i][5] = w1.y; wgt[i][6] = w1.z; wgt[i][7] = w1.w;
      }
#pragma unroll
      for (int rr = 0; rr < 8; ++rr) {
        float xf[8];
#pragma unroll
        for (int e = 0; e < 8; ++e) xf[e] = bf2f((u16)xr[rr][e]);
#pragma unroll
        for (int o = 0; o < 4; ++o) {
          const int i = rr - o;
          if (i >= 0 && i < 5) {
#pragma unroll
            for (int e = 0; e < 8; ++e) y[o][e] += wgt[i][e] * xf[e];
          }
        }
      }
#pragma unroll
      for (int o = 0; o < 4; ++o) {
        const int t = tbase + tg * 4 + o;
        float ss = 0.f;
#pragma unroll
        for (int e = 0; e < 8; ++e) {
          float v = y[o][e];
          v = (t >= 0) ? v * __builtin_amdgcn_rcpf(1.f + __expf(-v)) : 0.f;
          y[o][e] = v;
          ss += v * v;
        }
        if (pass < 2) {
          ss += __shfl_xor(ss, 1); ss += __shfl_xor(ss, 2); ss += __shfl_xor(ss, 4); ss += __shfl_xor(ss, 8);
          float sc = rsqrtf(ss + EPSF);
          if (pass == 0) sc *= 0.08838834764831845f;
#pragma unroll
          for (int e = 0; e < 8; ++e) y[o][e] *= sc;
          const int c = tg * 4 + o;
          uint4 pk = make_uint4(pack2(y[o][0], y[o][1]), pack2(y[o][2], y[o][3]), pack2(y[o][4], y[o][5]), pack2(y[o][6], y[o][7]));
          u16* dstL = pass == 0 ? qL : kL;
          *reinterpret_cast<uint4*>(dstL + c * 136 + cg_ * 8) = pk;
          if (pass == 0) {
            u16* gq = p.qn + cidx * 8192 + (size_t)c * 128;
            *reinterpret_cast<uint2*>(gq + sigma(cg_ * 8)) = make_uint2(pk.x, pk.y);
            *reinterpret_cast<uint2*>(gq + sigma(cg_ * 8 + 4)) = make_uint2(pk.z, pk.w);
          }
        }
      }
      if (pass >= 1) {
        u16* dT = (pass == 1 ? kT : vT) + sigma(tg * 4);
#pragma unroll
        for (int e = 0; e < 8; ++e)
          *reinterpret_cast<uint2*>(dT + (cg_ * 8 + e) * 72) = make_uint2(pack2(y[0][e], y[1][e]), pack2(y[2][e], y[3][e]));
      }
    }
  }
  __syncthreads();
  {
    const int row = tid >> 1, half = tid & 1;
    const uint4* s4 = reinterpret_cast<const uint4*>(kT + row * 72 + half * 32);
    uint4* d4 = reinterpret_cast<uint4*>(p.knT + cidx * 8192 + (size_t)row * 64 + half * 32);
    d4[0] = s4[0]; d4[1] = s4[1]; d4[2] = s4[2]; d4[3] = s4[3];
  }
  f32x4 kk[4], qk[4];
  {
#pragma unroll
    for (int jt = 0; jt < 4; ++jt) { kk[jt] = f32x4{0.f, 0.f, 0.f, 0.f}; qk[jt] = f32x4{0.f, 0.f, 0.f, 0.f}; }
#pragma unroll
    for (int ks = 0; ks < 4; ++ks) {
      bf16x8 bq = ld8(qL + (wv * 16 + l16) * 136 + ks * 32 + quad * 8);
      bf16x8 bk = ld8(kL + (wv * 16 + l16) * 136 + ks * 32 + quad * 8);
#pragma unroll
      for (int jt = 0; jt < 4; ++jt) {
        bf16x8 a = ld8(kL + (jt * 16 + l16) * 136 + ks * 32 + quad * 8);
        kk[jt] = mfma16(a, bk, kk[jt]);
        qk[jt] = mfma16(a, bq, qk[jt]);
      }
    }
  }
  __syncthreads();
  {
    const int i = wv * 16 + l16;
    const float gfi = gcv[i], gbi = gcv[64 + i], bfi = btv[i], bbi = btv[64 + i];
#pragma unroll
    for (int jt = 0; jt < 4; ++jt) {
      const int j0 = jt * 16 + quad * 4;
      f32x4 mf, mb, qf, qb;
#pragma unroll
      for (int jj = 0; jj < 4; ++jj) {
        const int j = j0 + jj;
        const float df = __expf(gfi - gcv[j]);
        const float db = __expf(gbi - gcv[64 + j]);
        mf[jj] = (i > j) ? bfi * kk[jt][jj] * df : 0.f;
        mb[jj] = (i < j) ? bbi * kk[jt][jj] * db : 0.f;
        qf[jj] = (i >= j) ? qk[jt][jj] * df : 0.f;
        qb[jj] = (i <= j) ? qk[jt][jj] * db : 0.f;
      }
      *reinterpret_cast<float4*>(G1 + i * 68 + j0) = make_float4(mf[0], mf[1], mf[2], mf[3]);
      *reinterpret_cast<float4*>(G2 + (63 - i) * 68 + (60 - j0)) = make_float4(mb[3], mb[2], mb[1], mb[0]);
      *reinterpret_cast<uint2*>(p.qkS + dcf * 4096 + (size_t)i * 64 + sigma(j0)) = pack4(qf);
      *reinterpret_cast<uint2*>(p.qkS + dcb * 4096 + (size_t)i * 64 + sigma(j0)) = pack4(qb);
    }
  }
  __syncthreads();
  if (wv < 2) {
    float* G = (wv == 0 ? G1 : G2) + (quad * 16) * 68 + quad * 16;
    float t[16];
#pragma unroll
    for (int i = 0; i < 16; ++i) {
      float a = (i == l16) ? 1.f : 0.f;
#pragma unroll
      for (int j = 0; j < i; ++j) a -= G[i * 68 + j] * t[j];
      t[i] = a;
      asm volatile("" ::: "memory");
    }
#pragma unroll
    for (int i = 0; i < 16; ++i) G[i * 68 + l16] = t[i];
  }
  __syncthreads();
  {
    float* G = ((wv >> 1) ? G2 : G1) + ((wv & 1) * 32) * 68 + (wv & 1) * 32;
    f32x4 x = f32x4{0.f, 0.f, 0.f, 0.f};
#pragma unroll
    for (int st = 0; st < 4; ++st)
      x = __builtin_amdgcn_mfma_f32_16x16x4f32(G[(16 + l16) * 68 + 4 * st + quad], G[(4 * st + quad) * 68 + l16], x, 0, 0, 0);
    f32x4 yv = f32x4{0.f, 0.f, 0.f, 0.f};
#pragma unroll
    for (int j = 0; j < 4; ++j)
      yv = __builtin_amdgcn_mfma_f32_16x16x4f32(G[(16 + l16) * 68 + 16 + 4 * quad + j], x[j], yv, 0, 0, 0);
#pragma unroll
    for (int j = 0; j < 4; ++j) G[(16 + quad * 4 + j) * 68 + l16] = -yv[j];
  }
  __syncthreads();
  {
    float* G = (wv >> 1) ? G2 : G1;
    const int cb = wv & 1;
    f32x4 x0 = f32x4{0.f, 0.f, 0.f, 0.f}, x1 = f32x4{0.f, 0.f, 0.f, 0.f};
#pragma unroll
    for (int st = 0; st < 8; ++st) {
      const float bv = G[(4 * st + quad) * 68 + cb * 16 + l16];
      x0 = __builtin_amdgcn_mfma_f32_16x16x4f32(G[(32 + l16) * 68 + 4 * st + quad], bv, x0, 0, 0, 0);
      x1 = __builtin_amdgcn_mfma_f32_16x16x4f32(G[(48 + l16) * 68 + 4 * st + quad], bv, x1, 0, 0, 0);
    }
    __syncthreads();
    f32x4 y0 = f32x4{0.f, 0.f, 0.f, 0.f}, y1 = f32x4{0.f, 0.f, 0.f, 0.f};
#pragma unroll
    for (int j = 0; j < 4; ++j) {
      y0 = __builtin_amdgcn_mfma_f32_16x16x4f32(G[(32 + l16) * 68 + 32 + 4 * quad + j], x0[j], y0, 0, 0, 0);
      y0 = __builtin_amdgcn_mfma_f32_16x16x4f32(G[(32 + l16) * 68 + 48 + 4 * quad + j], x1[j], y0, 0, 0, 0);
      y1 = __builtin_amdgcn_mfma_f32_16x16x4f32(G[(48 + l16) * 68 + 32 + 4 * quad + j], x0[j], y1, 0, 0, 0);
      y1 = __builtin_amdgcn_mfma_f32_16x16x4f32(G[(48 + l16) * 68 + 48 + 4 * quad + j], x1[j], y1, 0, 0, 0);
    }
#pragma unroll
    for (int j = 0; j < 4; ++j) {
      G[(32 + quad * 4 + j) * 68 + cb * 16 + l16] = -y0[j];
      G[(48 + quad * 4 + j) * 68 + cb * 16 + l16] = -y1[j];
    }
  }
  __syncthreads();
  {
    const int dir = wv >> 1, rh = wv & 1;
    const float* G = dir ? G2 : G1;
    float T[32];
#pragma unroll
    for (int i = 0; i < 32; ++i) T[i] = G[(rh * 32 + i) * 68 + lane];
    __syncthreads();
    const int jcol = dir == 0 ? lane : 63 - lane;
    const float bt = btv[dir * 64 + jcol];
    const float eg = expf(gcv[dir * 64 + jcol]);
    u16* Tu = Tb + (dir * 2 + 0) * (64 * 72);
    u16* Tw = Tb + (dir * 2 + 1) * (64 * 72);
    const int sj = sigma(jcol);
#pragma unroll
    for (int i = 0; i < 32; ++i) {
      const int i0 = rh * 32 + i;
      const int irow = dir == 0 ? i0 : 63 - i0;
      Tu[irow * 72 + sj] = f2bf(T[i] * bt);
      Tw[irow * 72 + sj] = f2bf(T[i] * bt * eg);
    }
  }
  __syncthreads();
  {
    const int dir = wv >> 1, which = wv & 1;
    const u16* Tm = Tb + (dir * 2 + which) * (64 * 72);
    const size_t dc = dir ? dcb : dcf;
    if (which == 0) {
      u16* dst = p.uT + dc * 8192;
#pragma unroll 1
      for (int dt = 0; dt < 8; ++dt) {
        bf16x8 b0 = ld8(vT + (dt * 16 + l16) * 72 + quad * 8);
        bf16x8 b1 = ld8(vT + (dt * 16 + l16) * 72 + 32 + quad * 8);
#pragma unroll
        for (int it = 0; it < 4; ++it) {
          f32x4 a = f32x4{0.f, 0.f, 0.f, 0.f};
          a = mfma16(ld8(Tm + (it * 16 + l16) * 72 + quad * 8), b0, a);
          a = mfma16(ld8(Tm + (it * 16 + l16) * 72 + 32 + quad * 8), b1, a);
          *reinterpret_cast<uint2*>(dst + (size_t)(dt * 16 + l16) * 64 + it * 16 + quad * 4) = pack4(a);
        }
      }
    } else {
      u16* dst = p.wS + dc * 8192;
#pragma unroll 1
      for (int dt = 0; dt < 8; ++dt) {
        bf16x8 a0 = ld8(kT + (dt * 16 + l16) * 72 + quad * 8);
        bf16x8 a1 = ld8(kT + (dt * 16 + l16) * 72 + 32 + quad * 8);
#pragma unroll
        for (int it = 0; it < 4; ++it) {
          f32x4 a = f32x4{0.f, 0.f, 0.f, 0.f};
          a = mfma16(a0, ld8(Tm + (it * 16 + l16) * 72 + quad * 8), a);
          a = mfma16(a1, ld8(Tm + (it * 16 + l16) * 72 + 32 + quad * 8), a);
          *reinterpret_cast<uint2*>(dst + (size_t)(it * 16 + l16) * 128 + sigma(dt * 16 + quad * 4)) = pack4(a);
        }
      }
    }
  }
}

constexpr int SC_WS = 288, SC_KS = 160;
constexpr int SC_W = 0, SC_Q = 64 * SC_WS, SC_K = 2 * 64 * SC_WS, SC_QK = SC_K + 128 * SC_KS, SC_E = SC_QK + 64 * SC_KS, SC_BUF = SC_E + 768;
__device__ void dn_scan_block(const Params& p, const int chain, char* smem, const int tid) {
  const int lane = tid & 63, l16 = lane & 15, quad = lane >> 4, wv = tid >> 6;
  const int dir = chain & 1, bh = chain >> 1;
  __syncthreads();
  if (wv >= 4) {
    const int lt = tid - 256;
    uint4 r0, r1, r2, r3, r4, r5, r6, r7, r8, r9, r10, r11, r12, r13, re;
    float rc;
    const int dwq = (lt >> 4) * SC_WS + (lt & 15) * 16;
    const int dkk = (lt >> 3) * SC_KS + (lt & 7) * 16;
#define SCAN_GLOAD(n_)                                                                                   \
    {                                                                                                    \
      const size_t cidx_ = (size_t)bh * NCH + (n_);                                                      \
      const size_t dc_ = ((size_t)bh * 2 + dir) * NCH + (n_);                                            \
      const uint4* w4 = reinterpret_cast<const uint4*>(p.wS + dc_ * 8192) + lt;                          \
      const uint4* q4 = reinterpret_cast<const uint4*>(p.qn + cidx_ * 8192) + lt;                        \
      const uint4* k4 = reinterpret_cast<const uint4*>(p.knT + cidx_ * 8192) + lt;                       \
      const uint4* g4 = reinterpret_cast<const uint4*>(p.qkS + dc_ * 4096) + lt;                         \
      r0 = w4[0]; r1 = w4[256]; r2 = w4[512]; r3 = w4[768];                                              \
      r4 = q4[0]; r5 = q4[256]; r6 = q4[512]; r7 = q4[768];                                              \
      r8 = k4[0]; r9 = k4[256]; r10 = k4[512]; r11 = k4[768];                                            \
      r12 = g4[0]; r13 = g4[256];                                                                        \
      re = reinterpret_cast<const uint4*>((lt < 16 ? p.egS : p.ekS) + dc_ * 64)[lt & 15];               \
      rc = p.cdS[dc_];                                                                                   \
    }
#define SCAN_SSTORE(buf_)                                                                                \
    {                                                                                                    \
      char* bb_ = smem + (buf_) * SC_BUF;                                                                \
      *reinterpret_cast<uint4*>(bb_ + SC_W + dwq) = r0; *reinterpret_cast<uint4*>(bb_ + SC_W + dwq + 16 * SC_WS) = r1; \
      *reinterpret_cast<uint4*>(bb_ + SC_W + dwq + 32 * SC_WS) = r2; *reinterpret_cast<uint4*>(bb_ + SC_W + dwq + 48 * SC_WS) = r3; \
      *reinterpret_cast<uint4*>(bb_ + SC_Q + dwq) = r4; *reinterpret_cast<uint4*>(bb_ + SC_Q + dwq + 16 * SC_WS) = r5; \
      *reinterpret_cast<uint4*>(bb_ + SC_Q + dwq + 32 * SC_WS) = r6; *reinterpret_cast<uint4*>(bb_ + SC_Q + dwq + 48 * SC_WS) = r7; \
      *reinterpret_cast<uint4*>(bb_ + SC_K + dkk) = r8; *reinterpret_cast<uint4*>(bb_ + SC_K + dkk + 32 * SC_KS) = r9; \
      *reinterpret_cast<uint4*>(bb_ + SC_K + dkk + 64 * SC_KS) = r10; *reinterpret_cast<uint4*>(bb_ + SC_K + dkk + 96 * SC_KS) = r11; \
      *reinterpret_cast<uint4*>(bb_ + SC_QK + dkk) = r12; *reinterpret_cast<uint4*>(bb_ + SC_QK + dkk + 32 * SC_KS) = r13; \
      if (lt < 32) *reinterpret_cast<uint4*>(bb_ + SC_E + lt * 16) = re;                                  \
      if (lt == 32) *reinterpret_cast<float*>(bb_ + SC_E + 512) = rc;                                     \
    }
    SCAN_GLOAD(dir ? (NCH - 1) : 0);
    SCAN_SSTORE(0);
    SCAN_GLOAD(dir ? (NCH - 2) : 1);
    __syncthreads();
#pragma unroll 1
    for (int step = 0; step < NCH; ++step) {
      if (step + 1 < NCH) {
        SCAN_SSTORE((step + 1) & 1);
        const int s2 = min(step + 2, NCH - 1);
        SCAN_GLOAD(dir ? (NCH - 1 - s2) : s2);
      }
      __syncthreads();
    }
#undef SCAN_GLOAD
#undef SCAN_SSTORE
  } else {
    f32x4 S0[8], S1[8];
#pragma unroll
    for (int k = 0; k < 8; ++k) { S0[k] = f32x4{0.f, 0.f, 0.f, 0.f}; S1[k] = f32x4{0.f, 0.f, 0.f, 0.f}; }
    uint2 un00, un01, un02, un03, un10, un11, un12, un13;
#define SCAN_ULOAD(n_)                                                                                   \
    {                                                                                                    \
      const size_t dc_ = ((size_t)bh * 2 + dir) * NCH + (n_);                                            \
      const u16* up_ = p.uT + dc_ * 8192 + (size_t)(wv * 32 + l16) * 64 + quad * 4;                      \
      un00 = *reinterpret_cast<const uint2*>(up_); un01 = *reinterpret_cast<const uint2*>(up_ + 16);     \
      un02 = *reinterpret_cast<const uint2*>(up_ + 32); un03 = *reinterpret_cast<const uint2*>(up_ + 48); \
      un10 = *reinterpret_cast<const uint2*>(up_ + 1024); un11 = *reinterpret_cast<const uint2*>(up_ + 1040); \
      un12 = *reinterpret_cast<const uint2*>(up_ + 1056); un13 = *reinterpret_cast<const uint2*>(up_ + 1072); \
    }
    SCAN_ULOAD(dir ? (NCH - 1) : 0);
    __syncthreads();
#pragma unroll 1
    for (int step = 0; step < NCH; ++step) {
      const int n = dir ? (NCH - 1 - step) : step;
      const size_t dc = ((size_t)bh * 2 + dir) * NCH + n;
      const uint2 uc00 = un00, uc01 = un01, uc02 = un02, uc03 = un03, uc10 = un10, uc11 = un11, uc12 = un12, uc13 = un13;
      {
        const int s1 = min(step + 1, NCH - 1);
        SCAN_ULOAD(dir ? (NCH - 1 - s1) : s1);
      }
      const char* bb = smem + (step & 1) * SC_BUF;
      const u16* wp = reinterpret_cast<const u16*>(bb + SC_W);
      const u16* qp = reinterpret_cast<const u16*>(bb + SC_Q);
      const u16* kp = reinterpret_cast<const u16*>(bb + SC_K);
      const u16* qkp = reinterpret_cast<const u16*>(bb + SC_QK);
      const float* egp = reinterpret_cast<const float*>(bb + SC_E);
      const float* ekp = egp + 64;
      const float cd = egp[128];
      u16* up = p.uT + dc * 8192 + (size_t)(wv * 32 + l16) * 64;
      bf16x8 Sb0[4], Sb1[4];
#pragma unroll
      for (int ks = 0; ks < 4; ++ks) { Sb0[ks] = pack8(S0[2 * ks], S0[2 * ks + 1]); Sb1[ks] = pack8(S1[2 * ks], S1[2 * ks + 1]); }
      f32x4 vn0[4], vn1[4], oa0[4], oa1[4];
#pragma unroll
      for (int ct = 0; ct < 4; ++ct) {
        f32x4 a0 = f32x4{0.f, 0.f, 0.f, 0.f}, a1 = a0;
#pragma unroll
        for (int ks = 0; ks < 4; ++ks) {
          const bf16x8 wf = ld8(wp + (ct * 16 + l16) * (SC_WS / 2) + ks * 32 + quad * 8);
          a0 = mfma16(wf, Sb0[ks], a0); a1 = mfma16(wf, Sb1[ks], a1);
        }
        const uint2 u0 = (ct == 0) ? uc00 : (ct == 1) ? uc01 : (ct == 2) ? uc02 : uc03;
        const uint2 u1 = (ct == 0) ? uc10 : (ct == 1) ? uc11 : (ct == 2) ? uc12 : uc13;
        vn0[ct][0] = bf2f((u16)(u0.x & 0xffff)) - a0[0]; vn0[ct][1] = bf2f((u16)(u0.x >> 16)) - a0[1];
        vn0[ct][2] = bf2f((u16)(u0.y & 0xffff)) - a0[2]; vn0[ct][3] = bf2f((u16)(u0.y >> 16)) - a0[3];
        vn1[ct][0] = bf2f((u16)(u1.x & 0xffff)) - a1[0]; vn1[ct][1] = bf2f((u16)(u1.x >> 16)) - a1[1];
        vn1[ct][2] = bf2f((u16)(u1.y & 0xffff)) - a1[2]; vn1[ct][3] = bf2f((u16)(u1.y >> 16)) - a1[3];
      }
#pragma unroll
      for (int ct = 0; ct < 4; ++ct) {
        f32x4 o0 = f32x4{0.f, 0.f, 0.f, 0.f}, o1 = o0;
#pragma unroll
        for (int ks = 0; ks < 4; ++ks) {
          const bf16x8 qf = ld8(qp + (ct * 16 + l16) * (SC_WS / 2) + ks * 32 + quad * 8);
          o0 = mfma16(qf, Sb0[ks], o0); o1 = mfma16(qf, Sb1[ks], o1);
        }
        const float4 eg = *reinterpret_cast<const float4*>(egp + ct * 16 + quad * 4);
        oa0[ct][0] = o0[0] * eg.x; oa0[ct][1] = o0[1] * eg.y; oa0[ct][2] = o0[2] * eg.z; oa0[ct][3] = o0[3] * eg.w;
        oa1[ct][0] = o1[0] * eg.x; oa1[ct][1] = o1[1] * eg.y; oa1[ct][2] = o1[2] * eg.z; oa1[ct][3] = o1[3] * eg.w;
      }
      bf16x8 Vb0[2], Vb1[2], Eb0[2], Eb1[2];
#pragma unroll
      for (int k2 = 0; k2 < 2; ++k2) {
        Vb0[k2] = pack8(vn0[2 * k2], vn0[2 * k2 + 1]);
        Vb1[k2] = pack8(vn1[2 * k2], vn1[2 * k2 + 1]);
        const float4 e0 = *reinterpret_cast<const float4*>(ekp + (2 * k2) * 16 + quad * 4);
        const float4 e1 = *reinterpret_cast<const float4*>(ekp + (2 * k2 + 1) * 16 + quad * 4);
        f32x4 x0 = vn0[2 * k2], x1 = vn0[2 * k2 + 1], y0 = vn1[2 * k2], y1 = vn1[2 * k2 + 1];
        x0[0] *= e0.x; x0[1] *= e0.y; x0[2] *= e0.z; x0[3] *= e0.w;
        x1[0] *= e1.x; x1[1] *= e1.y; x1[2] *= e1.z; x1[3] *= e1.w;
        y0[0] *= e0.x; y0[1] *= e0.y; y0[2] *= e0.z; y0[3] *= e0.w;
        y1[0] *= e1.x; y1[1] *= e1.y; y1[2] *= e1.z; y1[3] *= e1.w;
        Eb0[k2] = pack8(x0, x1);
        Eb1[k2] = pack8(y0, y1);
      }
#pragma unroll
      for (int ct = 0; ct < 4; ++ct) {
        f32x4 o0 = oa0[ct], o1 = oa1[ct];
#pragma unroll
        for (int k2 = 0; k2 < 2; ++k2) {
          const bf16x8 gf = ld8(qkp + (ct * 16 + l16) * (SC_KS / 2) + k2 * 32 + quad * 8);
          o0 = mfma16(gf, Vb0[k2], o0); o1 = mfma16(gf, Vb1[k2], o1);
        }
        *reinterpret_cast<uint2*>(up + ct * 16 + quad * 4) = pack4(o0);
        *reinterpret_cast<uint2*>(up + 1024 + ct * 16 + quad * 4) = pack4(o1);
      }
#pragma unroll
      for (int kt = 0; kt < 8; ++kt) {
        f32x4 s0 = S0[kt] * cd, s1 = S1[kt] * cd;
#pragma unroll
        for (int k2 = 0; k2 < 2; ++k2) {
          const bf16x8 kf = ld8(kp + (kt * 16 + l16) * (SC_KS / 2) + k2 * 32 + quad * 8);
          s0 = mfma16(kf, Eb0[k2], s0); s1 = mfma16(kf, Eb1[k2], s1);
        }
        S0[kt] = s0; S1[kt] = s1;
      }
      __syncthreads();
    }
#undef SCAN_ULOAD
  }
}

__device__ void dn_combine(const Params& p, int item, char* smem, const int tid) {
  const int h = item & 3, n = (item >> 2) % NCH, b = item / (4 * NCH);
  float* sl = (float*)smem;
  const size_t dcf = ((size_t)(b * 4 + h) * 2 + 0) * NCH + n;
  const size_t dcb = ((size_t)(b * 4 + h) * 2 + 1) * NCH + n;
  const int c = tid >> 2, part = tid & 3;
  const int t = n * 64 - 48 + c;
  const size_t mrow = (size_t)b * LL + (t >= 0 ? t : 0);
  u16* dp = p.proj + mrow * PW + PC_Z + h * 128 + part * 32;
  const bf16x8 z0 = ld8(dp), z1 = ld8(dp + 8), z2 = ld8(dp + 16), z3 = ld8(dp + 24);
  __syncthreads();
#pragma unroll
  for (int i = 0; i < 4; ++i) {
    const int e8 = tid + i * 256;
    const int v = e8 >> 3, c0 = (e8 & 7) * 8;
    bf16x8 a = ld8(p.uT + dcf * 8192 + (size_t)e8 * 8);
    bf16x8 bb = ld8(p.uT + dcb * 8192 + (size_t)e8 * 8);
#pragma unroll
    for (int e = 0; e < 8; ++e) sl[v * 65 + (v >> 5) * 8 + c0 + e] = bf2f((u16)a[e]) + bf2f((u16)bb[e]);
  }
  __syncthreads();
  float vals[32];
  float ss = 0.f;
#pragma unroll
  for (int e = 0; e < 32; ++e) { float v = sl[(part * 32 + e) * 65 + part * 8 + c]; vals[e] = v; ss += v * v; }
  ss += __shfl_xor(ss, 1); ss += __shfl_xor(ss, 2);
  const float rs = rsqrtf(ss * (1.f / 128.f) + EPSF);
  if (t >= 0) {
#pragma unroll
    for (int e8 = 0; e8 < 4; ++e8) {
      const bf16x8 z = (e8 == 0) ? z0 : (e8 == 1) ? z1 : (e8 == 2) ? z2 : z3;
      float r[8];
#pragma unroll
      for (int e = 0; e < 8; ++e) {
        float zz = bf2f((u16)z[e]);
        r[e] = vals[e8 * 8 + e] * rs * p.norm_g[part * 32 + e8 * 8 + e] * (zz * __builtin_amdgcn_rcpf(1.f + __expf(-zz)));
      }
      *reinterpret_cast<uint4*>(dp + e8 * 8) = make_uint4(pack2(r[0], r[1]), pack2(r[2], r[3]), pack2(r[4], r[5]), pack2(r[6], r[7]));
    }
  }
}

__device__ void final_norm(const Params& p) {
  const int lane = threadIdx.x & 63;
  const int gw = blockIdx.x * (NTHR / 64) + (threadIdx.x >> 6), nw = gridDim.x * (NTHR / 64);
  float4 g[2][2];
#pragma unroll
  for (int q = 0; q < 2; ++q) {
    g[q][0] = *reinterpret_cast<const float4*>(p.g_final + q * 512 + lane * 8);
    g[q][1] = *reinterpret_cast<const float4*>(p.g_final + q * 512 + lane * 8 + 4);
  }
  for (int row = gw * 4; row < MC; row += nw * 4) {
    uint4 v[4][2];
    float rs[4];
#pragma unroll
    for (int r = 0; r < 4; ++r) {
      const u16* src = p.h2b + (size_t)(row + r) * DM + lane * 8;
      v[r][0] = *reinterpret_cast<const uint4*>(src); v[r][1] = *reinterpret_cast<const uint4*>(src + 512);
      rs[r] = p.ss3[row + r];
    }
#pragma unroll
    for (int r = 0; r < 4; ++r) {
      const float sc = rsqrtf(rs[r] * (1.f / DM) + EPSF);
      float* dst = p.out + (size_t)(row + r) * DM + lane * 8;
#pragma unroll
      for (int q = 0; q < 2; ++q) {
        const uint4 w = v[r][q];
        const float4 a = make_float4(__uint_as_float(w.x << 16) * sc * g[q][0].x, __uint_as_float(w.x & 0xffff0000u) * sc * g[q][0].y,
                                     __uint_as_float(w.y << 16) * sc * g[q][0].z, __uint_as_float(w.y & 0xffff0000u) * sc * g[q][0].w);
        const float4 c = make_float4(__uint_as_float(w.z << 16) * sc * g[q][1].x, __uint_as_float(w.z & 0xffff0000u) * sc * g[q][1].y,
                                     __uint_as_float(w.w << 16) * sc * g[q][1].z, __uint_as_float(w.w & 0xffff0000u) * sc * g[q][1].w);
        *reinterpret_cast<float4*>(dst + q * 512) = a;
        *reinterpret_cast<float4*>(dst + q * 512 + 4) = c;
      }
    }
  }
}

#define XB_TMO      128
#define XB_XCNT(j)  (256  + 64 * (j))
#define XB_XSUB(j)  (1280 + 64 * (j))
#define XB_XGEN(j)  (2304 + 64 * (j))
#define XB_TOP      3328
#define XB_TOPGEN   3392
#define XCD_BAR_WORDS 3456
#define XB_SPIN_CAP (1u << 18)
__device__ __forceinline__ unsigned xb_ld(unsigned* p)              { return __hip_atomic_load(p, __ATOMIC_RELAXED, __HIP_MEMORY_SCOPE_AGENT); }
__device__ __forceinline__ unsigned xb_add(unsigned* p, unsigned v) { return __hip_atomic_fetch_add(p, v, __ATOMIC_RELAXED, __HIP_MEMORY_SCOPE_AGENT); }
__device__ __forceinline__ unsigned xb_xcc_id() { return (unsigned)__builtin_amdgcn_s_getreg((3 << 11) | 20) & 0xFu; }
#define XB_SPIN(cond, bar) do { unsigned _sp = 0; while (cond) { __builtin_amdgcn_s_sleep(1); \
    if ((++_sp & 255u) == 0u) { if (xb_ld(&(bar)[XB_TMO])) break; if (_sp > XB_SPIN_CAP) { atomicAdd(&(bar)[XB_TMO], 1u); break; } } } } while (0)
struct XcdBarrier { unsigned* bar; unsigned x; volatile LAS unsigned* st; };
__device__ __forceinline__ XcdBarrier xcd_barrier_post(unsigned* bar, volatile LAS unsigned* st) {
  XcdBarrier b; b.bar = bar; b.x = xb_xcc_id(); b.st = st;
  if (threadIdx.x == 0) (void)xb_add(&bar[XB_XCNT(b.x)], 1u);
  return b;
}
__device__ __forceinline__ void xcd_barrier_complete(unsigned* bar, unsigned x, unsigned& nloc, unsigned& nx) {
  const unsigned G = gridDim.x * gridDim.y * gridDim.z;
  unsigned sum, cnt, mine, sp = 0u;
  for (;;) {
    sum = 0u; cnt = 0u; mine = 0u;
#pragma unroll
    for (unsigned j = 0; j < 16; ++j) { const unsigned c = xb_ld(&bar[XB_XCNT(j)]); sum += c; cnt += (c > 0u) ? 1u : 0u; mine = (j == x) ? c : mine; }
    if (sum == G) break;
    __builtin_amdgcn_s_sleep(1);
    if ((++sp & 255u) == 0u) { if (xb_ld(&bar[XB_TMO])) break; if (sp > XB_SPIN_CAP) { atomicAdd(&bar[XB_TMO], 1u); break; } }
  }
  nloc = mine > 0u ? mine : 1u; nx = cnt > 0u ? cnt : 1u;
}
__device__ __forceinline__ void xcd_barrier(const XcdBarrier& b) {
  asm volatile("s_waitcnt vmcnt(0)" ::: "memory");
  __syncthreads();
  if (threadIdx.x == 0) {
    unsigned* bar = b.bar;
    __builtin_amdgcn_s_waitcnt(0);
    unsigned nloc = b.st[0], nx = b.st[1];
    if (nloc == 0u) { xcd_barrier_complete(bar, b.x, nloc, nx); b.st[0] = nloc; b.st[1] = nx; }
    const unsigned old = xb_add(&bar[XB_XSUB(b.x)], 1u);
    const unsigned gen = old / nloc;
    if (old + 1u == (gen + 1u) * nloc) {
      __builtin_amdgcn_fence(__ATOMIC_RELEASE, "agent");
      asm volatile("s_waitcnt vmcnt(0)" ::: "memory");
      const unsigned og = xb_add(&bar[XB_TOP], 1u);
      const unsigned tg = og / nx;
      if (og + 1u == (tg + 1u) * nx) xb_add(&bar[XB_TOPGEN], 1u);
      else XB_SPIN(xb_ld(&bar[XB_TOPGEN]) == tg, bar);
      __builtin_amdgcn_fence(__ATOMIC_ACQUIRE, "agent");
      xb_add(&bar[XB_XGEN(b.x)], 1u);
      asm volatile("s_waitcnt vmcnt(0)" ::: "memory");
    } else {
      XB_SPIN(xb_ld(&bar[XB_XGEN(b.x)]) == gen, bar);
      __builtin_amdgcn_fence(__ATOMIC_ACQUIRE, "agent");
      asm volatile("s_waitcnt vmcnt(0)" ::: "memory");
    }
  }
  __syncthreads();
}

__global__ void __launch_bounds__(NTHR, 2) mega(Params p) {
  extern __shared__ __attribute__((aligned(16))) char smem[];
  cg::grid_group grid = cg::this_grid();
  volatile LAS unsigned* xbst = (volatile LAS unsigned*)(smem + LDS_BYTES);
  if (threadIdx.x == 0) { xbst[0] = 0u; xbst[1] = 0u; xbst[2] = 0u; xbst[3] = 0u; }
  __syncthreads();
  XcdBarrier xb; xb.bar = p.bar; xb.x = xb_xcc_id(); xb.st = xbst;
  if (blockIdx.x == 0) for (int i = threadIdx.x; i < XCD_BAR_WORDS; i += NTHR) p.bar[i] = 0u;
  const int lo = p.phase_lo, hi = p.phase_hi;
#define PH_BEGIN(n) if (lo <= (n) && (n) < hi) { if ((n) > lo) { if ((n) == 1) { grid.sync(); if (threadIdx.x == 0) (void)xb_add(&p.bar[XB_XCNT(xb.x)], 1u); } else xcd_barrier(xb); } int otid_ = threadIdx.x; asm volatile("" : "+v"(otid_)); const int half = otid_ >> 8, tid2 = otid_ & 255; char* hsm = smem + half * HLDS; (void)tid2; (void)hsm;
#define PH_END }
  PH_BEGIN(0) phase0(p, smem); PH_END
  PH_BEGIN(1) { gemm_phase<1, false>(p, (LAS unsigned char*)smem, p.hb, DM, p.WinT, INP / BM, DM); meta_inproj(p); } PH_END
  PH_BEGIN(2) {
    const int NDN = NB * NCH * 4;
    for (int it = blockIdx.x * 2 + half; it < NDN; it += gridDim.x * 2) dn_prep(p, it, hsm, tid2);
  } PH_END
  PH_BEGIN(3) {
    const bool split = gridDim.x > 64;
    const int nsc = split ? 64 : (int)gridDim.x;
    if ((int)blockIdx.x < nsc)
      for (int ch = blockIdx.x; ch < 64; ch += nsc) dn_scan_block(p, ch, smem, otid_);
    const int nb = split ? (int)blockIdx.x - 64 : (int)blockIdx.x;
    if (nb >= 0) na_items(p, hsm, tid2, nb * 2 + half, (split ? (int)gridDim.x - 64 : (int)gridDim.x) * 2);
  } PH_END
  PH_BEGIN(4) {
    for (int it = blockIdx.x * 2 + half; it < NB * NCH * 4; it += gridDim.x * 2) dn_combine(p, it, hsm, tid2);
  } PH_END
  PH_BEGIN(5) gemm_phase<3, true>(p, (LAS unsigned char*)smem, p.proj, PW, p.WoutT, DM / BM, DM); PH_END
  PH_BEGIN(6) gemm_phase<4, false>(p, (LAS unsigned char*)smem, p.h1b, DM, p.WguT, (2 * DFF) / BM, DM); PH_END
  PH_BEGIN(7) gemm_phase<5, false>(p, (LAS unsigned char*)smem, p.act, DFF, p.WdT, DM / BM, DFF); PH_END
  PH_BEGIN(8) final_norm(p); PH_END
}

static inline size_t al256(size_t v) { return (v + 255) & ~(size_t)255; }

extern "C" void kernel_launch(void* const* d_in, const int* in_sizes, int n_in, void* d_out, int out_size, void* d_ws, size_t ws_size,
                              hipStream_t stream) {
  static int grid_blocks = 0;
  if (!grid_blocks) {
    int dev = 0, cus = 0, per_cu = 0;
    hipGetDevice(&dev);
    hipDeviceGetAttribute(&cus, hipDeviceAttributeMultiprocessorCount, dev);
    hipFuncSetAttribute((const void*)mega, hipFuncAttributeMaxDynamicSharedMemorySize, LDS_BYTES + 16);
    hipOccupancyMaxActiveBlocksPerMultiprocessor(&per_cu, (const void*)mega, NTHR, LDS_BYTES + 16);
    if (per_cu < 1) per_cu = 1;
    if (per_cu > 1) per_cu = 1;
    grid_blocks = cus * per_cu;
    grid_blocks &= ~7;
    fprintf(stderr, "mega: cus %d per_cu %d grid %d ws %zu\n", cus, per_cu, grid_blocks, ws_size);
  }
  Params p{};
  p.x = (const float*)d_in[0]; p.meta = (const float*)d_in[1]; p.g_mix = (const float*)d_in[2]; p.w_in = (const float*)d_in[3];
  p.rel_bias = (const float*)d_in[4]; p.conv_w = (const float*)d_in[5]; p.a_log = (const float*)d_in[6]; p.dt_bias = (const float*)d_in[7];
  p.norm_g = (const float*)d_in[8]; p.w_out = (const float*)d_in[9]; p.g_ffn = (const float*)d_in[10]; p.w_gate = (const float*)d_in[11];
  p.w_up = (const float*)d_in[12]; p.w_down = (const float*)d_in[13]; p.g_final = (const float*)d_in[14];
  p.out = (float*)d_out;
  char* ws = (char*)d_ws;
  size_t off = 0;
  auto take = [&](size_t bytes) { char* r = ws + off; off += al256(bytes); return r; };
  p.WinT = (u16*)take((size_t)INP * DM * 2);
  p.WoutT = (u16*)take((size_t)DM * DM * 2);
  p.WguT = (u16*)take((size_t)2 * DFF * DM * 2);
  p.WdT = (u16*)take((size_t)DM * DFF * 2);
  p.bar = (unsigned*)take((size_t)XCD_BAR_WORDS * 4);
  p.rs1 = (float*)take((size_t)MT * 4);
  p.ss2 = (float*)take((size_t)MT * 4);
  p.ss3 = (float*)take((size_t)MT * 4);
  char* preg = take((size_t)MT * PW * 2);
  p.proj = (u16*)preg;
  p.act = (u16*)preg;
  p.Vt = (u16*)take((size_t)NB * 512 * LL * 2);
  char* xreg = ws + off;
  p.hb = (u16*)xreg;
  {
    size_t o2 = 0;
    auto tk = [&](size_t bytes) { char* r = xreg + o2; o2 += al256(bytes); return r; };
    const size_t NCK = (size_t)NB * 4 * NCH;
    p.qn = (u16*)tk(NCK * 8192 * 2);
    p.knT = (u16*)tk(NCK * 8192 * 2);
    p.uT = (u16*)tk(2 * NCK * 8192 * 2);
    p.wS = (u16*)tk(2 * NCK * 8192 * 2);
    p.qkS = (u16*)tk(2 * NCK * 4096 * 2);
    p.egS = (float*)tk(2 * NCK * 64 * 4);
    p.ekS = (float*)tk(2 * NCK * 64 * 4);
    p.cdS = (float*)tk(2 * NCK * 4);
    if (off + o2 > ws_size) fprintf(stderr, "mega: workspace too small: need %zu have %zu\n", off + o2, ws_size);
  }
  p.h1 = (float*)xreg;
  p.h2b = (u16*)xreg;
  p.h1b = (u16*)(xreg + al256((size_t)MC * DM * 4));
  p.phase_lo = 0; p.phase_hi = 9;
  void* args[] = {&p};
  hipError_t e = hipLaunchCooperativeKernel((const void*)mega, dim3(grid_blocks), dim3(NTHR), args, LDS_BYTES + 16, stream);
  if (e != hipSuccess) fprintf(stderr, "cooperative launch failed: %s (grid %d)\n", hipGetErrorString(e), grid_blocks);
}
```

```cpp
#include <hip/hip_runtime.h>
#include <hip/hip_bf16.h>
#include <hip/hip_cooperative_groups.h>
#include <cstdio>
namespace cg = cooperative_groups;

typedef unsigned short u16;
using bf16x8 = __attribute__((ext_vector_type(8))) short;
using s16x4 = __attribute__((ext_vector_type(4))) short;
using f32x4 = __attribute__((ext_vector_type(4))) float;

constexpr int DM = 1024, NB = 8, SEQ = 8192, NMETA = 16, LL = SEQ + NMETA, MT = NB * LL;
constexpr int INW = 3600, INP = 3840, PW = 3136;
constexpr int MC = NB * SEQ;
constexpr int DFF = 2816;
constexpr int NCH = 129;
constexpr int NTHR = 512;
constexpr int HLDS = 77824;
constexpr int LDS_BYTES = 2 * HLDS;
constexpr float EPSF = 1e-6f;

constexpr int PC_NAQ = 0, PC_Z = 512, PC_NAK = 1024, PC_DNQ = 1536, PC_DNK = 2048, PC_DNV = 2560, PC_B = 3072, PC_A = 3080;

struct Params {
  const float *x, *meta, *g_mix, *w_in, *rel_bias, *conv_w, *a_log, *dt_bias, *norm_g, *w_out, *g_ffn, *w_gate, *w_up, *w_down, *g_final;
  float* out;
  u16 *WinT, *WoutT, *WguT, *WdT;
  float *rs1, *ss2, *ss3;
  u16* hb;
  u16* proj;
  u16* Vt;
  u16 *qn, *knT, *uT, *wS, *qkS;
  float *egS, *ekS, *cdS;
  float* h1;
  u16* h2b;
  u16* h1b;
  u16* act;
  unsigned* bar;
  int phase_lo, phase_hi;
};

__device__ __forceinline__ float bf2f(u16 h) { return __uint_as_float(((unsigned)h) << 16); }
typedef __bf16 bf16x2_t __attribute__((ext_vector_type(2)));
typedef float f32x2_t __attribute__((ext_vector_type(2)));
__device__ __forceinline__ unsigned pack2(float a, float b) { f32x2_t v = {a, b}; bf16x2_t r = __builtin_convertvector(v, bf16x2_t); return __builtin_bit_cast(unsigned, r); }
__device__ __forceinline__ u16 f2bf(float f) { return (u16)(pack2(f, 0.f) & 0xffffu); }
__device__ __forceinline__ uint2 pack4(f32x4 v) { return make_uint2(pack2(v[0], v[1]), pack2(v[2], v[3])); }
__device__ __forceinline__ bf16x8 pack8(f32x4 a, f32x4 b) {
  union { bf16x8 v; unsigned u[4]; } r;
  r.u[0] = pack2(a[0], a[1]); r.u[1] = pack2(a[2], a[3]); r.u[2] = pack2(b[0], b[1]); r.u[3] = pack2(b[2], b[3]);
  return r.v;
}
__device__ __forceinline__ bf16x8 ld8(const u16* p) { return *reinterpret_cast<const bf16x8*>(p); }
__device__ __forceinline__ bf16x8 ld4x2(const u16* p0, const u16* p1) {
  union { bf16x8 v; uint2 u[2]; } r;
  r.u[0] = *reinterpret_cast<const uint2*>(p0);
  r.u[1] = *reinterpret_cast<const uint2*>(p1);
  return r.v;
}
__device__ __forceinline__ f32x4 mfma16(bf16x8 a, bf16x8 b, f32x4 c) { return __builtin_amdgcn_mfma_f32_16x16x32_bf16(a, b, c, 0, 0, 0); }
__device__ __forceinline__ int sigma(int c) { return (c & ~31) | (((c >> 2) & 3) << 3) | (((c >> 4) & 1) << 2) | (c & 3); }

__device__ void wprep_tile(const Params& p, int item, char* smem, const int tid) {
  float* tl = (float*)smem;
  int type, tr, tk;
  if (item < 960) { type = 0; tr = item / 16; tk = item % 16; }
  else if (item < 1216) { item -= 960; type = 1; tr = item / 16; tk = item % 16; }
  else if (item < 2624) { item -= 1216; type = 2; tr = item / 16; tk = item % 16; }
  else { item -= 2624; type = 3; tr = item / 44; tk = item % 44; }
  int r0 = tr * 64 + (tid & 15) * 4;
  const float* src; int sstride; bool valid = true; const float* gain = nullptr; u16* dst; int kd = 1024;
  if (type == 0) { src = p.w_in + r0; sstride = INW; valid = r0 < INW; gain = p.g_mix; dst = p.WinT; }
  else if (type == 1) { src = p.w_out + r0; sstride = 1024; dst = p.WoutT; }
  else if (type == 2) { int grp = r0 >> 8, wi = r0 & 255; int ff = grp * 128 + (wi & 127); src = (wi < 128 ? p.w_gate : p.w_up) + ff; sstride = DFF; gain = p.g_ffn; dst = p.WguT; }
  else { src = p.w_down + r0; sstride = 1024; dst = p.WdT; kd = DFF; }
  __syncthreads();
#pragma unroll
  for (int i = 0; i < 4; ++i) {
    int kk = (tid >> 4) + 16 * i;
    int k = tk * 64 + kk;
    float4 v = make_float4(0.f, 0.f, 0.f, 0.f);
    if (valid) v = *reinterpret_cast<const float4*>(src + (size_t)k * sstride);
    float g = gain ? gain[k] : 1.f;
    int nn = (tid & 15) * 4;
    tl[(nn + 0) * 65 + kk] = v.x * g; tl[(nn + 1) * 65 + kk] = v.y * g; tl[(nn + 2) * 65 + kk] = v.z * g; tl[(nn + 3) * 65 + kk] = v.w * g;
  }
  __syncthreads();
  int n = tid >> 2, ks = (tid & 3) * 16;
  unsigned o[8];
#pragma unroll
  for (int e = 0; e < 8; ++e) o[e] = pack2(tl[n * 65 + ks + 2 * e], tl[n * 65 + ks + 2 * e + 1]);
  u16* d = dst + (size_t)(tr * 64 + n) * kd + tk * 64 + ks;
  *reinterpret_cast<uint4*>(d) = make_uint4(o[0], o[1], o[2], o[3]);
  *reinterpret_cast<uint4*>(d + 8) = make_uint4(o[4], o[5], o[6], o[7]);
}

__device__ void phase0(const Params& p, char* smem) {
  const int NW = 3328;
  const int half = threadIdx.x >> 8, tid = threadIdx.x & 255;
  for (int it = blockIdx.x * 2 + half; it < NW; it += gridDim.x * 2) wprep_tile(p, it, smem + half * HLDS, tid);
  int lane = threadIdx.x & 63, wv = threadIdx.x >> 6;
  for (int row0 = (blockIdx.x * 8 + wv) * 2; row0 < MC + NMETA; row0 += gridDim.x * 16) {
    float4 v[2][4];
#pragma unroll
    for (int r = 0; r < 2; ++r) {
      const int row = row0 + r;
      const float* src = (row < MC) ? (p.x + (size_t)row * DM) : (p.meta + (size_t)(row - MC) * DM);
#pragma unroll
      for (int i = 0; i < 4; ++i) v[r][i] = *reinterpret_cast<const float4*>(src + i * 256 + lane * 4);
    }
#pragma unroll
    for (int r = 0; r < 2; ++r) {
      const int row = row0 + r;
      float ss = 0.f;
#pragma unroll
      for (int i = 0; i < 4; ++i) {
        const float4 w = v[r][i];
        ss += w.x * w.x + w.y * w.y + w.z * w.z + w.w * w.w;
      }
#pragma unroll
      for (int o = 32; o >= 1; o >>= 1) ss += __shfl_xor(ss, o);
      const float rs = rsqrtf(ss * (1.f / DM) + EPSF);
#pragma unroll
      for (int i = 0; i < 4; ++i) {
        const float4 w = v[r][i];
        *reinterpret_cast<uint2*>(p.hb + (size_t)row * DM + i * 256 + lane * 4) = make_uint2(pack2(w.x * rs, w.y * rs), pack2(w.z * rs, w.w * rs));
      }
      if (lane == 0 && row < MC) { p.ss2[row] = 0.f; p.ss3[row] = 0.f; }
    }
  }
}

#define LAS __attribute__((address_space(3)))
constexpr int BM = 256, BK = 64, HALF = 128, HTB = HALF * BK * 2, STAGE_BYTES = 8 * HTB, NXCD = 8, WGM = 4;
__device__ __forceinline__ int lds_byte(int r, int c) { const int st = (r >> 4) * 2 + (c >> 5), rr = r & 15, cc = c & 31, ob = rr * 64 + cc * 2; return st * 1024 + (ob ^ (((ob >> 9) & 1) << 5)); }
__device__ __forceinline__ void stage_rc(int b, int& R, int& C) { const int st = b / 1024, sb = b % 1024, swz = sb ^ (((sb >> 9) & 1) << 5); R = (st >> 1) * 16 + swz / 64; C = (st & 1) * 32 + (swz % 64) / 2; }
__device__ __forceinline__ int perm32(int rho) { const int n = rho >> 4, i = rho & 15; return 8 * (i >> 2) + 4 * n + (i & 3); }
struct Unit { int pm, pn; };
struct StaticOrder {
  int nM, nN, nwg, G, c;
  __device__ void init(int nM_, int nN_, int G_, int c_) { nM = nM_; nN = nN_; nwg = nM * nN; G = G_; c = c_; }
  __device__ bool next(int i, Unit& u) const {
    const long L = (long)i * G + c; if (L >= nwg) return false;
    int wgid = (int)L; { const int q = nwg / NXCD, r = nwg % NXCD, xcd = wgid % NXCD, off = wgid / NXCD; wgid = (xcd < r ? xcd * (q + 1) : r * (q + 1) + (xcd - r) * q) + off; }
    const int nig = WGM * nN, gid = wgid / nig, fm = gid * WGM, gsz = (nM - fm) < WGM ? (nM - fm) : WGM;
    u.pm = fm + ((wgid % nig) % gsz); u.pn = (wgid % nig) / gsz; return true;
  }
};

__device__ __forceinline__ int proj_col(int c) {
  if (c < 512) return PC_NAQ + c;
  if (c < 1024) return PC_NAK + (c - 512);
  if (c < 1536) return -1;
  if (c < 2048) return PC_DNQ + (c - 1536);
  if (c < 2560) return PC_DNK + (c - 2048);
  if (c < 3072) return PC_DNV + (c - 2560);
  if (c < 3584) return PC_Z + (c - 3072);
  if (c < 3592) return PC_B + (c - 3584);
  if (c < 3600) return PC_A + (c - 3592);
  return -2;
}

template <int EPI>
__device__ __forceinline__ void gemm_epi(const Params& p, const f32x4 (&acc)[2][2][4][2], const Unit& u, int wr, int wc, int fr, int fq) {
  const int mc0 = u.pm * BM + wr * 64 + fr;
  if constexpr (EPI == 1 || EPI == 4) {
    float rsv[2][4];
#pragma unroll
    for (int ai = 0; ai < 2; ++ai)
#pragma unroll
      for (int m = 0; m < 4; ++m) {
        const int mc = mc0 + ai * HALF + m * 16;
        rsv[ai][m] = (EPI == 1) ? 1.f : p.ss2[mc];
      }
#pragma unroll
    for (int ai = 0; ai < 2; ++ai)
#pragma unroll
      for (int m = 0; m < 4; ++m) {
        const int mc = mc0 + ai * HALF + m * 16;
        if constexpr (EPI == 1) {
          const int b = mc >> 13, t = NMETA + (mc & 8191);
          const size_t mf = (size_t)b * LL + t;
#pragma unroll
          for (int bj = 0; bj < 2; ++bj) {
            const int c8 = u.pn * BM + bj * HALF + wc * 32 + fq * 8;
            const int col = proj_col(c8);
            f32x4 v0 = acc[ai][bj][m][0], v1 = acc[ai][bj][m][1];
            if (c8 < 512) { v0 = v0 * 0.125f; v1 = v1 * 0.125f; }
            if (col >= 0) {
              *reinterpret_cast<uint4*>(p.proj + mf * PW + col) = make_uint4(pack2(v0[0], v0[1]), pack2(v0[2], v0[3]), pack2(v1[0], v1[1]), pack2(v1[2], v1[3]));
            } else if (col == -1) {
              u16* vp = p.Vt + ((size_t)(b * 512 + c8 - 1024)) * LL + t;
#pragma unroll
              for (int j = 0; j < 4; ++j) { vp[(size_t)j * LL] = f2bf(v0[j]); vp[(size_t)(4 + j) * LL] = f2bf(v1[j]); }
            }
          }
        } else {
          const float r2 = rsqrtf(rsv[ai][m] * (1.f / DM) + EPSF);
          const int ff8 = u.pn * HALF + wc * 32 + fq * 8;
          float a[8];
#pragma unroll
          for (int n = 0; n < 2; ++n)
#pragma unroll
            for (int j = 0; j < 4; ++j) {
              const float g = acc[ai][0][m][n][j] * r2, uu = acc[ai][1][m][n][j] * r2;
              a[n * 4 + j] = g * __builtin_amdgcn_rcpf(1.f + __expf(-g)) * uu;
            }
          *reinterpret_cast<uint4*>(p.act + (size_t)mc * DFF + ff8) = make_uint4(pack2(a[0], a[1]), pack2(a[2], a[3]), pack2(a[4], a[5]), pack2(a[6], a[7]));
        }
      }
  } else {
    const int c80 = u.pn * BM + wc * 32 + fq * 8;
#pragma unroll
    for (int ai = 0; ai < 2; ++ai) {
      float4 rx[4][2][2];
      uint4 rh[4][2];
#pragma unroll
      for (int m = 0; m < 4; ++m) {
        const int mc = mc0 + ai * HALF + m * 16;
#pragma unroll
        for (int bj = 0; bj < 2; ++bj) {
          if constexpr (EPI == 3) {
            const float* res = p.x + (size_t)mc * DM + c80 + bj * HALF;
            rx[m][bj][0] = *reinterpret_cast<const float4*>(res); rx[m][bj][1] = *reinterpret_cast<const float4*>(res + 4);
          } else {
            rh[m][bj] = *reinterpret_cast<const uint4*>(p.h1b + (size_t)mc * DM + c80 + bj * HALF);
          }
        }
      }
#pragma unroll
      for (int m = 0; m < 4; ++m) {
        const int mc = mc0 + ai * HALF + m * 16;
        float ss = 0.f;
#pragma unroll
        for (int bj = 0; bj < 2; ++bj) {
          const int c8 = c80 + bj * HALF;
          f32x4 v0 = acc[ai][bj][m][0], v1 = acc[ai][bj][m][1];
          if constexpr (EPI == 3) {
            const float4 r0 = rx[m][bj][0], r1 = rx[m][bj][1];
            v0[0] += r0.x; v0[1] += r0.y; v0[2] += r0.z; v0[3] += r0.w;
            v1[0] += r1.x; v1[1] += r1.y; v1[2] += r1.z; v1[3] += r1.w;
            *reinterpret_cast<uint4*>(p.h1b + (size_t)mc * DM + c8) = make_uint4(pack2(v0[0], v0[1]), pack2(v0[2], v0[3]), pack2(v1[0], v1[1]), pack2(v1[2], v1[3]));
          } else {
            const uint4 rb = rh[m][bj];
            v0[0] += __uint_as_float(rb.x << 16); v0[1] += __uint_as_float(rb.x & 0xffff0000u);
            v0[2] += __uint_as_float(rb.y << 16); v0[3] += __uint_as_float(rb.y & 0xffff0000u);
            v1[0] += __uint_as_float(rb.z << 16); v1[1] += __uint_as_float(rb.z & 0xffff0000u);
            v1[2] += __uint_as_float(rb.w << 16); v1[3] += __uint_as_float(rb.w & 0xffff0000u);
            *reinterpret_cast<uint4*>(p.h2b + (size_t)mc * DM + c8) = make_uint4(pack2(v0[0], v0[1]), pack2(v0[2], v0[3]), pack2(v1[0], v1[1]), pack2(v1[2], v1[3]));
          }
#pragma unroll
          for (int j = 0; j < 4; ++j) ss += v0[j] * v0[j] + v1[j] * v1[j];
        }
        ss += __shfl_xor(ss, 16); ss += __shfl_xor(ss, 32);
        if (fq == 0) atomicAdd(((EPI == 3) ? p.ss2 : p.ss3) + mc, ss);
      }
    }
  }
}

template <int EPI, bool ROWMAP>
__device__ __forceinline__ void gemm_phase(const Params& p, LAS unsigned char* lds, const u16* A, const int lda, const u16* Bt, const int nN, const int K) {
  const int tid = threadIdx.x, wid = __builtin_amdgcn_readfirstlane(tid >> 6), lane = tid & 63, wr = wid >> 2, wc = wid & 3, fr = lane & 15, fq = lane >> 4;
  const int nt = K / BK;
  StaticOrder S; S.init(MC / BM, nN, gridDim.x, blockIdx.x);
  unsigned voffA[2], voffB[2];
#pragma unroll
  for (int i = 0; i < 2; ++i) { int R, C; stage_rc(tid * 16 + i * 8192, R, C); const int Rb = (R & ~31) + perm32(R & 31);
    voffA[i] = (unsigned)(R * lda + C) * 2u; voffB[i] = (unsigned)(Rb * K + C) * 2u; }
  const size_t kstep = (size_t)(BK * 2);
  const size_t hstepA = (size_t)HALF * lda * 2, hstepB = (size_t)HALF * K * 2;
  const unsigned ldsw = (unsigned)wid * 1024u;
  const int aoff = lds_byte(wr * 64 + fr, fq * 8), boff = lds_byte(wc * 32 + fr, fq * 8);
#define PG8_ABASE(pm_) ((const char*)A + (size_t)(ROWMAP ? (((pm_) >> 5) * LL + NMETA + ((pm_) & 31) * BM) : (pm_) * BM) * lda * 2)
#define PG8_BBASE(pn_) ((const char*)Bt + (size_t)(pn_) * 2 * hstepB)
#define PG8_SA(b, h) (((b) * 2 + (h)) * HTB)
#define PG8_SB(b, h) ((4 + (b) * 2 + (h)) * HTB)
#define PG8_STAGE(bufoff, gbase, voff) do { _Pragma("unroll") for (int _i = 0; _i < 2; ++_i) \
    __builtin_amdgcn_global_load_lds((const unsigned*)((const char*)(gbase) + (voff)[_i]), (LAS unsigned*)(lds + (bufoff) + ldsw + _i * 8192), 16, 0, 0); } while (0)
#define PG8_LDA(dst, b, h) do { _Pragma("unroll") for (int m = 0; m < 4; ++m) _Pragma("unroll") for (int k = 0; k < 2; ++k) dst[m][k] = *(const LAS bf16x8*)(lds + PG8_SA(b, h) + aoff + m * 2048 + k * 1024); } while (0)
#define PG8_LDB(dst, b, h) do { _Pragma("unroll") for (int n = 0; n < 2; ++n) _Pragma("unroll") for (int k = 0; k < 2; ++k) dst[n][k] = *(const LAS bf16x8*)(lds + PG8_SB(b, h) + boff + n * 2048 + k * 1024); } while (0)
#define PG8_MMA(ai, bj, At, Bt_) do { __builtin_amdgcn_s_setprio(1); _Pragma("unroll") for (int m = 0; m < 4; ++m) _Pragma("unroll") for (int n = 0; n < 2; ++n) _Pragma("unroll") for (int k = 0; k < 2; ++k) \
    acc[ai][bj][m][n] = __builtin_amdgcn_mfma_f32_16x16x32_bf16(Bt_[n][k], At[m][k], acc[ai][bj][m][n], 0, 0, 0); __builtin_amdgcn_s_setprio(0); } while (0)
#define PG8_WAIT_V(n) asm volatile("s_waitcnt vmcnt(" #n ")" ::: "memory")
#define PG8_WAIT_L(n) asm volatile("s_waitcnt lgkmcnt(" #n ")" ::: "memory")
#define PG8_BAR __builtin_amdgcn_s_barrier()
#define PG8_SCHED __builtin_amdgcn_sched_barrier(0)
  Unit cur, nxt; int ui = 0;
  if (!S.next(0, cur)) return;
  f32x4 acc[2][2][4][2];
#pragma unroll
  for (int a = 0; a < 2; ++a)
#pragma unroll
    for (int b = 0; b < 2; ++b)
#pragma unroll
      for (int m = 0; m < 4; ++m)
#pragma unroll
        for (int n = 0; n < 2; ++n) acc[a][b][m][n] = f32x4{0.f, 0.f, 0.f, 0.f};
  bf16x8 At[4][2], B0[2][2], B1[2][2];
  const char* cA = PG8_ABASE(cur.pm); const char* cB = PG8_BBASE(cur.pn);
  PG8_STAGE(PG8_SB(0, 0), cB, voffB); PG8_STAGE(PG8_SA(0, 0), cA, voffA); PG8_STAGE(PG8_SB(0, 1), cB + hstepB, voffB); PG8_STAGE(PG8_SA(0, 1), cA + hstepA, voffA);
  if (wr == 1) PG8_BAR;
  PG8_WAIT_V(4); PG8_BAR;
  PG8_STAGE(PG8_SB(1, 0), cB + kstep, voffB); PG8_STAGE(PG8_SA(1, 0), cA + kstep, voffA); PG8_STAGE(PG8_SB(1, 1), cB + hstepB + kstep, voffB);
  PG8_WAIT_V(6); PG8_BAR;
  for (;;) {
    const bool has_next = S.next(ui + 1, nxt);
    const char* nA = has_next ? PG8_ABASE(nxt.pm) : cA; const char* nB = has_next ? PG8_BBASE(nxt.pn) : cB;
    for (int t = 0; t < nt; t += 2) {
      const bool last = (t == nt - 2);
      const char* a1 = cA + (size_t)(t + 1) * kstep;
      const char* a2 = last ? nA : cA + (size_t)(t + 2) * kstep; const char* b2 = last ? nB : cB + (size_t)(t + 2) * kstep;
      const char* a3 = a2 + kstep; const char* b3 = b2 + kstep;
      PG8_LDB(B0, 0, 0); PG8_SCHED; PG8_LDA(At, 0, 0); PG8_STAGE(PG8_SA(1, 1), a1 + hstepA, voffA);
      PG8_WAIT_L(8); PG8_BAR; PG8_WAIT_L(0); PG8_MMA(0, 0, At, B0); PG8_BAR; PG8_SCHED;
      PG8_LDB(B1, 0, 1); PG8_STAGE(PG8_SB(0, 0), b2, voffB);
      PG8_BAR; PG8_WAIT_L(0); PG8_MMA(0, 1, At, B1); PG8_BAR;
      PG8_LDA(At, 0, 1); PG8_STAGE(PG8_SA(0, 0), a2, voffA);
      PG8_BAR; PG8_WAIT_L(0); PG8_MMA(1, 0, At, B0); PG8_BAR; PG8_SCHED;
      PG8_STAGE(PG8_SB(0, 1), b2 + hstepB, voffB);
      PG8_WAIT_V(6); PG8_BAR; PG8_MMA(1, 1, At, B1); PG8_BAR;
      PG8_LDB(B0, 1, 0); PG8_SCHED; PG8_LDA(At, 1, 0); PG8_STAGE(PG8_SA(0, 1), a2 + hstepA, voffA);
      PG8_WAIT_L(8); PG8_BAR; PG8_WAIT_L(0); PG8_MMA(0, 0, At, B0); PG8_BAR; PG8_SCHED;
      PG8_LDB(B1, 1, 1); PG8_STAGE(PG8_SB(1, 0), b3, voffB);
      PG8_BAR; PG8_WAIT_L(0); PG8_MMA(0, 1, At, B1); PG8_BAR;
      PG8_LDA(At, 1, 1); PG8_STAGE(PG8_SA(1, 0), a3, voffA);
      PG8_BAR; PG8_WAIT_L(0); PG8_MMA(1, 0, At, B0); PG8_BAR; PG8_SCHED;
      PG8_STAGE(PG8_SB(1, 1), b3 + hstepB, voffB);
      PG8_WAIT_V(6); PG8_BAR; PG8_MMA(1, 1, At, B1); PG8_BAR;
    }
    gemm_epi<EPI>(p, acc, cur, wr, wc, fr, fq);
    if (!has_next) break;
#pragma unroll
    for (int a = 0; a < 2; ++a)
#pragma unroll
      for (int b = 0; b < 2; ++b)
#pragma unroll
        for (int m = 0; m < 4; ++m)
#pragma unroll
          for (int n = 0; n < 2; ++n) acc[a][b][m][n] = f32x4{0.f, 0.f, 0.f, 0.f};
    cur = nxt; cA = nA; cB = nB; ++ui;
  }
  PG8_WAIT_V(0);
  if (wr == 0) PG8_BAR;
  PG8_BAR;
#undef PG8_ABASE
#undef PG8_BBASE
#undef PG8_SA
#undef PG8_SB
#undef PG8_STAGE
#undef PG8_LDA
#undef PG8_LDB
#undef PG8_MMA
}

__device__ void meta_inproj(const Params& p) {
  const int lane = threadIdx.x & 63, l16 = lane & 15, quad = lane >> 4;
  for (int nt = blockIdx.x * 8 + (threadIdx.x >> 6); nt < INW / 16; nt += gridDim.x * 8) {
    f32x4 acc = f32x4{0.f, 0.f, 0.f, 0.f};
    const u16* wrow = p.WinT + (size_t)(nt * 16 + l16) * DM + quad * 8;
    const u16* arow = p.hb + (size_t)(MC + l16) * DM + quad * 8;
#pragma unroll 4
    for (int ks = 0; ks < 32; ++ks) acc = mfma16(ld8(wrow + ks * 32), ld8(arow + ks * 32), acc);
    const int c = nt * 16 + quad * 4;
    f32x4 v = acc;
    if (c < 512) v = v * 0.125f;
    const int col = proj_col(c);
    for (int b = 0; b < NB; ++b) {
      if (col >= 0) *reinterpret_cast<uint2*>(p.proj + ((size_t)b * LL + l16) * PW + col) = pack4(v);
      else if (col == -1) {
#pragma unroll
        for (int j = 0; j < 4; ++j) p.Vt[((size_t)(b * 512 + c - 1024 + j)) * LL + l16] = f2bf(v[j]);
      }
    }
  }
}

template <int NG>
__device__ __forceinline__ void na_wave(const Params& p, int b, int h, int qtok0, int r, int wq, int kr0, int jb0) {
  const int lane = threadIdx.x & 63, l16 = lane & 15, quad = lane >> 4;
  u16* proj = p.proj + (size_t)b * LL * PW;
  const u16* Vt = p.Vt + (size_t)(b * 512 + h * 64) * LL;
  const int qtok = qtok0 + l16;
  bf16x8 qf0 = ld8(proj + (size_t)qtok * PW + PC_NAQ + h * 64 + quad * 8);
  bf16x8 qf1 = ld8(proj + (size_t)qtok * PW + PC_NAQ + h * 64 + 32 + quad * 8);
  constexpr int NTL = NG + 1;
  f32x4 sc[NTL];
  const int qc = wq * 16 + l16;
  const int cs = min(max(qc - 8, 0), 48);
  const float* bias_h = p.rel_bias + h * (15 * 31);
#pragma unroll
  for (int t = 0; t < NG; ++t) {
    const int i = t / 3, jj = t % 3;
    const int ktok = NMETA + (kr0 + i) * 64 + (jb0 + jj) * 16 + l16;
    const u16* kp = proj + (size_t)ktok * PW + PC_NAK + h * 64 + quad * 8;
    f32x4 a = f32x4{0.f, 0.f, 0.f, 0.f};
    a = mfma16(ld8(kp), qf0, a);
    a = mfma16(ld8(kp + 32), qf1, a);
    const float* brow = bias_h + (kr0 + i - r + 7) * 31;
#pragma unroll
    for (int j = 0; j < 4; ++j) {
      const int kc = (jb0 + jj) * 16 + quad * 4 + j;
      const int dc = min(max(kc - qc, -15), 15) + 15;
      const bool in = (kc >= cs) && (kc < cs + 16);
      a[j] = in ? (a[j] + brow[dc]) : -1e30f;
    }
    sc[t] = a;
    if (t % 3 == 2) asm volatile("" ::: "memory");
  }
  {
    const u16* kp = proj + (size_t)l16 * PW + PC_NAK + h * 64 + quad * 8;
    f32x4 a = f32x4{0.f, 0.f, 0.f, 0.f};
    a = mfma16(ld8(kp), qf0, a);
    a = mfma16(ld8(kp + 32), qf1, a);
    sc[NG] = a;
  }
  float mx = -1e30f;
#pragma unroll
  for (int t = 0; t < NTL; ++t)
#pragma unroll
    for (int j = 0; j < 4; ++j) mx = fmaxf(mx, sc[t][j]);
  mx = fmaxf(mx, __shfl_xor(mx, 16));
  mx = fmaxf(mx, __shfl_xor(mx, 32));
  float sum = 0.f;
#pragma unroll
  for (int t = 0; t < NTL; ++t)
#pragma unroll
    for (int j = 0; j < 4; ++j) { float e = __expf(sc[t][j] - mx); sc[t][j] = e; sum += e; }
  sum += __shfl_xor(sum, 16);
  sum += __shfl_xor(sum, 32);
  const float inv = 1.f / sum;
  f32x4 o[4];
#pragma unroll
  for (int d = 0; d < 4; ++d) o[d] = f32x4{0.f, 0.f, 0.f, 0.f};
#pragma unroll
  for (int pr = 0; pr < NG / 2; ++pr) {
    const int t0 = 2 * pr, t1 = 2 * pr + 1;
    const int tok0 = NMETA + (kr0 + t0 / 3) * 64 + (jb0 + t0 % 3) * 16 + quad * 4;
    const int tok1 = NMETA + (kr0 + t1 / 3) * 64 + (jb0 + t1 % 3) * 16 + quad * 4;
    bf16x8 pf = pack8(sc[t0], sc[t1]);
#pragma unroll
    for (int d = 0; d < 4; ++d) {
      const u16* vr = Vt + (size_t)(d * 16 + l16) * LL;
      o[d] = mfma16(ld4x2(vr + tok0, vr + tok1), pf, o[d]);
    }
    if (pr & 1) asm volatile("" ::: "memory");
  }
  {
    f32x4 z = f32x4{0.f, 0.f, 0.f, 0.f};
    bf16x8 pf = pack8(sc[NG], z);
#pragma unroll
    for (int d = 0; d < 4; ++d) {
      const u16* vr = Vt + (size_t)(d * 16 + l16) * LL;
      union { bf16x8 v; uint2 u[2]; } vf;
      vf.u[0] = *reinterpret_cast<const uint2*>(vr + quad * 4);
      vf.u[1] = make_uint2(0u, 0u);
      o[d] = mfma16(vf.v, pf, o[d]);
    }
  }
#pragma unroll
  for (int d = 0; d < 4; ++d) {
    f32x4 v = o[d] * inv;
    *reinterpret_cast<uint2*>(proj + (size_t)qtok * PW + PC_NAQ + h * 64 + d * 16 + quad * 4) = pack4(v);
  }
}

__device__ void na_item(const Params& p, int item) {
  const int wv = (threadIdx.x >> 6) & 3;
  if (item < 8192) {
    const int h = item & 7, r = (item >> 3) & 127, b = item >> 10;
    const int kr0 = min(max(r - 4, 0), 120);
    const int jb0 = min(max(wv - 1, 0), 1);
    na_wave<24>(p, b, h, NMETA + r * 64 + wv * 16, r, wv, kr0, jb0);
  } else {
    item -= 8192;
    if (wv == 0) na_wave<0>(p, item >> 3, item & 7, 0, 0, 0, 0, 0);
  }
}

__device__ __forceinline__ f32x4 na_tile(const int t, const u16* KL, const int jb0, const int l16, const int quad, const bf16x8 qf0, const bf16x8 qf1,
                                         const float* bias_h, const int dr0, const int qc, const int cs) {
  const int i = t / 3, jj = t % 3;
  const u16* kp = KL + (i * 64 + (jb0 + jj) * 16 + l16) * 72 + quad * 8;
  f32x4 a = f32x4{0.f, 0.f, 0.f, 0.f};
  a = mfma16(ld8(kp), qf0, a);
  a = mfma16(ld8(kp + 32), qf1, a);
  const float* brow = bias_h + (dr0 + i) * 31;
#pragma unroll
  for (int j = 0; j < 4; ++j) {
    const int kc = (jb0 + jj) * 16 + quad * 4 + j;
    const int dc = min(max(kc - qc, -15), 15) + 15;
    const bool in = (kc >= cs) && (kc < cs + 16);
    a[j] = in ? (a[j] + brow[dc]) : -1e30f;
  }
  return a;
}
constexpr int NA_VS = 536;
__device__ void na_items(const Params& p, char* hsm, const int tid_in, const int first_item, const int stride) {
  int tid = tid_in;
  asm volatile("" : "+v"(tid));
  const int lane = tid & 63, wv = tid >> 6, l16 = lane & 15, quad = lane >> 4;
  u16* KL = (u16*)hsm;
  u16* VT = (u16*)hsm;
  uint4 k0, k1, k2, k3, k4, k5, k6, k7, k8, k9, k10, k11, k12, k13, k14, k15, km;
  bf16x8 qf0, qf1;
  float kbias;
  const int jb0 = min(max(wv - 1, 0), 1);
  const int qc = wv * 16 + l16;
  const int cs = min(max(qc - 8, 0), 48);
  float* BL = (float*)(hsm + 76032);
  const int brow_ = min(tid / 31, 7), bcol_ = tid % 31;
#define NA_KLOAD(item_)                                                                                              \
  {                                                                                                                  \
    const int h_ = (item_) & 7, r_ = ((item_) >> 3) & 127, b_ = (item_) >> 10;                                        \
    const int kr0_ = min(max(r_ - 4, 0), 120);                                                                       \
    const u16* pb_ = p.proj + (size_t)b_ * LL * PW;                                                                  \
    const u16* kp_ = pb_ + (size_t)(NMETA + kr0_ * 64 + (tid >> 3)) * PW + PC_NAK + h_ * 64 + (tid & 7) * 8;         \
    k0 = *reinterpret_cast<const uint4*>(kp_); k1 = *reinterpret_cast<const uint4*>(kp_ + (size_t)32 * PW);         \
    k2 = *reinterpret_cast<const uint4*>(kp_ + (size_t)64 * PW); k3 = *reinterpret_cast<const uint4*>(kp_ + (size_t)96 * PW);   \
    k4 = *reinterpret_cast<const uint4*>(kp_ + (size_t)128 * PW); k5 = *reinterpret_cast<const uint4*>(kp_ + (size_t)160 * PW); \
    k6 = *reinterpret_cast<const uint4*>(kp_ + (size_t)192 * PW); k7 = *reinterpret_cast<const uint4*>(kp_ + (size_t)224 * PW); \
    k8 = *reinterpret_cast<const uint4*>(kp_ + (size_t)256 * PW); k9 = *reinterpret_cast<const uint4*>(kp_ + (size_t)288 * PW); \
    k10 = *reinterpret_cast<const uint4*>(kp_ + (size_t)320 * PW); k11 = *reinterpret_cast<const uint4*>(kp_ + (size_t)352 * PW); \
    k12 = *reinterpret_cast<const uint4*>(kp_ + (size_t)384 * PW); k13 = *reinterpret_cast<const uint4*>(kp_ + (size_t)416 * PW); \
    k14 = *reinterpret_cast<const uint4*>(kp_ + (size_t)448 * PW); k15 = *reinterpret_cast<const uint4*>(kp_ + (size_t)480 * PW); \
    km = *reinterpret_cast<const uint4*>(pb_ + (size_t)((tid >> 3) & 15) * PW + PC_NAK + h_ * 64 + (tid & 7) * 8);    \
    const u16* qp_ = pb_ + (size_t)(NMETA + r_ * 64 + wv * 16 + l16) * PW + PC_NAQ + h_ * 64 + quad * 8;            \
    qf0 = ld8(qp_); qf1 = ld8(qp_ + 32);                                                                             \
    kbias = p.rel_bias[h_ * 465 + (kr0_ - r_ + 7 + brow_) * 31 + bcol_];                                            \
  }
  int item = first_item;
  { const int it0 = item < 8192 ? item : 0; NA_KLOAD(it0); }
  for (; item < 8192; item += stride) {
    const int h = item & 7, r = (item >> 3) & 127, b = item >> 10;
    const int kr0 = min(max(r - 4, 0), 120);
    u16* proj = p.proj + (size_t)b * LL * PW;
    __syncthreads();
    {
      u16* kd = KL + (tid >> 3) * 64 + (((tid & 7) ^ ((tid >> 3) & 7)) * 8);
      *reinterpret_cast<uint4*>(kd) = k0; *reinterpret_cast<uint4*>(kd + 32 * 64) = k1; *reinterpret_cast<uint4*>(kd + 64 * 64) = k2;
      *reinterpret_cast<uint4*>(kd + 96 * 64) = k3; *reinterpret_cast<uint4*>(kd + 128 * 64) = k4; *reinterpret_cast<uint4*>(kd + 160 * 64) = k5;
      *reinterpret_cast<uint4*>(kd + 192 * 64) = k6; *reinterpret_cast<uint4*>(kd + 224 * 64) = k7; *reinterpret_cast<uint4*>(kd + 256 * 64) = k8;
      *reinterpret_cast<uint4*>(kd + 288 * 64) = k9; *reinterpret_cast<uint4*>(kd + 320 * 64) = k10; *reinterpret_cast<uint4*>(kd + 352 * 64) = k11;
      *reinterpret_cast<uint4*>(kd + 384 * 64) = k12; *reinterpret_cast<uint4*>(kd + 416 * 64) = k13; *reinterpret_cast<uint4*>(kd + 448 * 64) = k14;
      *reinterpret_cast<uint4*>(kd + 480 * 64) = k15;
      if (tid < 128) *reinterpret_cast<uint4*>(kd + 512 * 64) = km;
      if (tid < 248) BL[brow_ * 32 + bcol_] = kbias;
    }
    __syncthreads();
    uint4 v0, v1, v2, v3, vm;
    const u16* vb = p.Vt + (size_t)(b * 512 + h * 64) * LL;
    const u16* vp = vb + (size_t)(tid >> 6) * LL + NMETA + kr0 * 64 + (tid & 63) * 8;
    {
      v0 = *reinterpret_cast<const uint4*>(vp); v1 = *reinterpret_cast<const uint4*>(vp + (size_t)4 * LL);
      v2 = *reinterpret_cast<const uint4*>(vp + (size_t)8 * LL); v3 = *reinterpret_cast<const uint4*>(vp + (size_t)12 * LL);
      vm = *reinterpret_cast<const uint4*>(vb + (size_t)((tid >> 1) & 63) * LL + (tid & 1) * 8);
    }
    f32x4 sc[25];
    {
      int dco[12]; bool inm[12];
#pragma unroll
      for (int jj = 0; jj < 3; ++jj)
#pragma unroll
        for (int j = 0; j < 4; ++j) {
          const int kc = (jb0 + jj) * 16 + quad * 4 + j;
          dco[jj * 4 + j] = min(max(kc - qc, -15), 15) + 15;
          inm[jj * 4 + j] = (kc >= cs) && (kc < cs + 16);
        }
      const u16* kbase = KL + (jb0 * 16 + l16) * 64;
      const int ko0 = ((quad ^ (l16 & 7)) * 8), ko1 = (((4 + quad) ^ (l16 & 7)) * 8);
#pragma unroll
      for (int i = 0; i < 8; ++i) {
#pragma unroll
        for (int jj = 0; jj < 3; ++jj) {
          const u16* kp = kbase + (i * 64 + jj * 16) * 64;
          f32x4 a = f32x4{0.f, 0.f, 0.f, 0.f};
          a = mfma16(ld8(kp + ko0), qf0, a);
          a = mfma16(ld8(kp + ko1), qf1, a);
#pragma unroll
          for (int j = 0; j < 4; ++j) a[j] = inm[jj * 4 + j] ? (a[j] + BL[i * 32 + dco[jj * 4 + j]]) : -1e30f;
          sc[i * 3 + jj] = a;
        }
        asm volatile("" ::: "memory");
      }
    }
    {
      const u16* kp = KL + (512 + l16) * 64;
      f32x4 a = f32x4{0.f, 0.f, 0.f, 0.f};
      a = mfma16(ld8(kp + ((quad ^ (l16 & 7)) * 8)), qf0, a);
      a = mfma16(ld8(kp + (((4 + quad) ^ (l16 & 7)) * 8)), qf1, a);
      sc[24] = a;
    }
    float mx = -1e30f;
#pragma unroll
    for (int t = 0; t < 25; ++t)
#pragma unroll
      for (int j = 0; j < 4; ++j) mx = fmaxf(mx, sc[t][j]);
    mx = fmaxf(mx, __shfl_xor(mx, 16));
    mx = fmaxf(mx, __shfl_xor(mx, 32));
    float sum = 0.f;
#pragma unroll
    for (int t = 0; t < 25; ++t)
#pragma unroll
      for (int j = 0; j < 4; ++j) { float e = __expf(sc[t][j] - mx); sc[t][j] = e; sum += e; }
    sum += __shfl_xor(sum, 16);
    sum += __shfl_xor(sum, 32);
    const float inv = 1.f / sum;
    bf16x8 pf[13];
#pragma unroll
    for (int pr = 0; pr < 12; ++pr) pf[pr] = pack8(sc[2 * pr], sc[2 * pr + 1]);
    pf[12] = pack8(sc[24], f32x4{0.f, 0.f, 0.f, 0.f});
    asm volatile("" ::: "memory");
    uint4 v4, v5, v6, v7, v8, v9, v10, v11, v12, v13, v14, v15;
    {
      v4 = *reinterpret_cast<const uint4*>(vp + (size_t)16 * LL); v5 = *reinterpret_cast<const uint4*>(vp + (size_t)20 * LL);
      v6 = *reinterpret_cast<const uint4*>(vp + (size_t)24 * LL); v7 = *reinterpret_cast<const uint4*>(vp + (size_t)28 * LL);
      v8 = *reinterpret_cast<const uint4*>(vp + (size_t)32 * LL); v9 = *reinterpret_cast<const uint4*>(vp + (size_t)36 * LL);
      v10 = *reinterpret_cast<const uint4*>(vp + (size_t)40 * LL); v11 = *reinterpret_cast<const uint4*>(vp + (size_t)44 * LL);
      v12 = *reinterpret_cast<const uint4*>(vp + (size_t)48 * LL); v13 = *reinterpret_cast<const uint4*>(vp + (size_t)52 * LL);
      v14 = *reinterpret_cast<const uint4*>(vp + (size_t)56 * LL); v15 = *reinterpret_cast<const uint4*>(vp + (size_t)60 * LL);
    }
    __syncthreads();
    u16* vd = VT + (tid >> 6) * NA_VS + (tid & 63) * 8;
    {
      *reinterpret_cast<uint4*>(vd) = v0; *reinterpret_cast<uint4*>(vd + 4 * NA_VS) = v1; *reinterpret_cast<uint4*>(vd + 8 * NA_VS) = v2;
      *reinterpret_cast<uint4*>(vd + 12 * NA_VS) = v3;
      if (tid < 128) *reinterpret_cast<uint4*>(VT + (tid >> 1) * NA_VS + 512 + (tid & 1) * 8) = vm;
    }
    __syncthreads();
    const int qtok = NMETA + r * 64 + wv * 16 + l16;
    f32x4 o[4];
#pragma unroll
    for (int d = 0; d < 4; ++d) o[d] = f32x4{0.f, 0.f, 0.f, 0.f};
#define NA_PV(d_lo, d_hi)                                                                       \
    {                                                                                           \
      _Pragma("unroll") for (int pr = 0; pr < 12; ++pr) {                                       \
        const int t0 = 2 * pr, t1 = 2 * pr + 1;                                                 \
        const int tokA = (t0 / 3) * 64 + (jb0 + t0 % 3) * 16 + quad * 4;                        \
        const int tokB = (t1 / 3) * 64 + (jb0 + t1 % 3) * 16 + quad * 4;                        \
        _Pragma("unroll") for (int d = d_lo; d < d_hi; ++d) {                                   \
          const u16* vr = VT + (d * 16 + l16) * NA_VS;                                          \
          o[d] = mfma16(ld4x2(vr + tokA, vr + tokB), pf[pr], o[d]);                             \
        }                                                                                       \
        if (pr % 2 == 1) asm volatile("" ::: "memory");                                         \
      }                                                                                         \
      _Pragma("unroll") for (int d = d_lo; d < d_hi; ++d) {                                     \
        const u16* vr = VT + (d * 16 + l16) * NA_VS + 512 + quad * 4;                           \
        union { bf16x8 v; uint2 u[2]; } vf;                                                     \
        vf.u[0] = *reinterpret_cast<const uint2*>(vr);                                          \
        vf.u[1] = make_uint2(0u, 0u);                                                           \
        o[d] = mfma16(vf.v, pf[12], o[d]);                                                      \
      }                                                                                         \
    }
    NA_PV(0, 1);
    {
      *reinterpret_cast<uint4*>(vd + 16 * NA_VS) = v4; *reinterpret_cast<uint4*>(vd + 20 * NA_VS) = v5;
      *reinterpret_cast<uint4*>(vd + 24 * NA_VS) = v6; *reinterpret_cast<uint4*>(vd + 28 * NA_VS) = v7;
      *reinterpret_cast<uint4*>(vd + 32 * NA_VS) = v8; *reinterpret_cast<uint4*>(vd + 36 * NA_VS) = v9; *reinterpret_cast<uint4*>(vd + 40 * NA_VS) = v10;
      *reinterpret_cast<uint4*>(vd + 44 * NA_VS) = v11; *reinterpret_cast<uint4*>(vd + 48 * NA_VS) = v12; *reinterpret_cast<uint4*>(vd + 52 * NA_VS) = v13;
      *reinterpret_cast<uint4*>(vd + 56 * NA_VS) = v14; *reinterpret_cast<uint4*>(vd + 60 * NA_VS) = v15;
    }
    __syncthreads();
    {
      const int nx = (item + stride < 8192) ? (item + stride) : item;
      NA_KLOAD(nx);
    }
    NA_PV(1, 4);
#undef NA_PV
#pragma unroll
    for (int d = 0; d < 4; ++d) {
      f32x4 v = o[d] * inv;
      *reinterpret_cast<uint2*>(proj + (size_t)qtok * PW + PC_NAQ + h * 64 + d * 16 + quad * 4) = pack4(v);
    }
  }
#undef NA_KLOAD
  for (; item < 8192 + 64; item += stride)
    if (wv == 0) na_wave<0>(p, (item - 8192) >> 3, item & 7, 0, 0, 0, 0, 0);
}

__device__ void dn_prep(const Params& p, int item, char* smem, const int tid_in) {
  int tid = tid_in;
  asm volatile("" : "+v"(tid));
  const int h = item & 3, n = (item >> 2) % NCH, b = item / (4 * NCH);
  const int lane = tid & 63, wv = tid >> 6, l16 = lane & 15, quad = lane >> 4;
  u16* qL = (u16*)smem;
  u16* kL = qL + 64 * 136;
  float* G1 = (float*)smem;
  float* G2 = G1 + 64 * 68;
  u16* Tb = (u16*)smem;
  u16* kT = (u16*)(smem + 36864);
  u16* vT = kT + 128 * 72;
  float* vec = (float*)(smem + 36864 + 36864);
  float* gcv = vec;
  float* btv = vec + 128;
  const size_t cidx = (size_t)(b * 4 + h) * NCH + n;
  const size_t dcf = ((size_t)(b * 4 + h) * 2 + 0) * NCH + n;
  const size_t dcb = ((size_t)(b * 4 + h) * 2 + 1) * NCH + n;
  const int tbase = n * 64 - 48;
  __syncthreads();
  if (tid < 128) {
    const int dir = wv, c = lane;
    const int t = tbase + c;
    float beta = 0.f, g = 0.f;
    if (t >= 0) {
      const size_t m = (size_t)b * LL + t;
      float bv = bf2f(p.proj[m * PW + PC_B + dir * 4 + h]);
      float av = bf2f(p.proj[m * PW + PC_A + dir * 4 + h]);
      beta = 1.f / (1.f + expf(-bv));
      float xx = av + p.dt_bias[dir * 4 + h];
      float sp = (xx > 20.f) ? xx : log1pf(expf(xx));
      g = -expf(p.a_log[dir * 4 + h]) * sp;
    }
    float s = g;
    if (dir == 0) {
#pragma unroll
      for (int o = 1; o < 64; o <<= 1) { float y = __shfl_up(s, o); if (lane >= o) s += y; }
    } else {
#pragma unroll
      for (int o = 1; o < 64; o <<= 1) { float y = __shfl_down(s, o); if (lane + o < 64) s += y; }
    }
    gcv[dir * 64 + c] = s;
    btv[dir * 64 + c] = beta;
    const float tot = __shfl(s, dir == 0 ? 63 : 0);
    const size_t dc = dir ? dcb : dcf;
    p.egS[dc * 64 + c] = expf(s);
    p.ekS[dc * 64 + c] = expf(tot - s);
    if (lane == 0) p.cdS[dc] = expf(tot);
  }
  {
    const int cg_ = tid & 15, tg = tid >> 4;
#pragma unroll 1
    for (int pass = 0; pass < 3; ++pass) {
      const int pcol = PC_DNQ + pass * 512 + h * 128 + cg_ * 8;
      const int wcol = pass * 512 + h * 128 + cg_ * 8;
      bf16x8 xr[8];
#pragma unroll
      for (int rr = 0; rr < 8; ++rr) {
        const int t = tbase + tg * 4 - 2 + rr;
        if (t >= 0 && t < LL) xr[rr] = ld8(p.proj + ((size_t)b * LL + t) * PW + pcol);
        else xr[rr] = bf16x8{0, 0, 0, 0, 0, 0, 0, 0};
      }
      float y[4][8];
#pragma unroll
      for (int o = 0; o < 4; ++o)
#pragma unroll
        for (int e = 0; e < 8; ++e) y[o][e] = 0.f;
      float wgt[5][8];
#pragma unroll
      for (int i = 0; i < 5; ++i) {
        float4 w0 = *reinterpret_cast<const float4*>(p.conv_w + (size_t)i * 1536 + wcol);
        float4 w1 = *reinterpret_cast<const float4*>(p.conv_w + (size_t)i * 1536 + wcol + 4);
        wgt[i][0] = w0.x; wgt[i][1] = w0.y; wgt[i][2] = w0.z; wgt[i][3] = w0.w; wgt[i][4] = w1.x; wgt[i][5] = w1.y; wgt[i][6] = w1.z; wgt[i][7] = w1.w;
      }
#pragma unroll
      for (int rr = 0; rr < 8; ++rr) {
        float xf[8];
#pragma unroll
        for (int e = 0; e < 8; ++e) xf[e] = bf2f((u16)xr[rr][e]);
#pragma unroll
        for (int o = 0; o < 4; ++o) {
          const int i = rr - o;
          if (i >= 0 && i < 5) {
#pragma unroll
            for (int e = 0; e < 8; ++e) y[o][e] += wgt[i][e] * xf[e];
          }
        }
      }
#pragma unroll
      for (int o = 0; o < 4; ++o) {
        const int t = tbase + tg * 4 + o;
        float ss = 0.f;
#pragma unroll
        for (int e = 0; e < 8; ++e) {
          float v = y[o][e];
          v = (t >= 0) ? v * __builtin_amdgcn_rcpf(1.f + __expf(-v)) : 0.f;
          y[o][e] = v;
          ss += v * v;
        }
        if (pass < 2) {
          ss += __shfl_xor(ss, 1); ss += __shfl_xor(ss, 2); ss += __shfl_xor(ss, 4); ss += __shfl_xor(ss, 8);
          float sc = rsqrtf(ss + EPSF);
          if (pass == 0) sc *= 0.08838834764831845f;
#pragma unroll
          for (int e = 0; e < 8; ++e) y[o][e] *= sc;
          const int c = tg * 4 + o;
          uint4 pk = make_uint4(pack2(y[o][0], y[o][1]), pack2(y[o][2], y[o][3]), pack2(y[o][4], y[o][5]), pack2(y[o][6], y[o][7]));
          u16* dstL = pass == 0 ? qL : kL;
          *reinterpret_cast<uint4*>(dstL + c * 136 + cg_ * 8) = pk;
          if (pass == 0) {
            u16* gq = p.qn + cidx * 8192 + (size_t)c * 128;
            *reinterpret_cast<uint2*>(gq + sigma(cg_ * 8)) = make_uint2(pk.x, pk.y);
            *reinterpret_cast<uint2*>(gq + sigma(cg_ * 8 + 4)) = make_uint2(pk.z, pk.w);
          }
        }
      }
      if (pass >= 1) {
        u16* dT = (pass == 1 ? kT : vT) + sigma(tg * 4);
#pragma unroll
        for (int e = 0; e < 8; ++e)
          *reinterpret_cast<uint2*>(dT + (cg_ * 8 + e) * 72) = make_uint2(pack2(y[0][e], y[1][e]), pack2(y[2][e], y[3][e]));
      }
    }
  }
  __syncthreads();
  {
    const int row = tid >> 1, half = tid & 1;
    const uint4* s4 = reinterpret_cast<const uint4*>(kT + row * 72 + half * 32);
    uint4* d4 = reinterpret_cast<uint4*>(p.knT + cidx * 8192 + (size_t)row * 64 + half * 32);
    d4[0] = s4[0]; d4[1] = s4[1]; d4[2] = s4[2]; d4[3] = s4[3];
  }
  f32x4 kk[4], qk[4];
  {
#pragma unroll
    for (int jt = 0; jt < 4; ++jt) { kk[jt] = f32x4{0.f, 0.f, 0.f, 0.f}; qk[jt] = f32x4{0.f, 0.f, 0.f, 0.f}; }
#pragma unroll
    for (int ks = 0; ks < 4; ++ks) {
      bf16x8 bq = ld8(qL + (wv * 16 + l16) * 136 + ks * 32 + quad * 8);
      bf16x8 bk = ld8(kL + (wv * 16 + l16) * 136 + ks * 32 + quad * 8);
#pragma unroll
      for (int jt = 0; jt < 4; ++jt) {
        bf16x8 a = ld8(kL + (jt * 16 + l16) * 136 + ks * 32 + quad * 8);
        kk[jt] = mfma16(a, bk, kk[jt]);
        qk[jt] = mfma16(a, bq, qk[jt]);
      }
    }
  }
  __syncthreads();
  {
    const int i = wv * 16 + l16;
    const float gfi = gcv[i], gbi = gcv[64 + i], bfi = btv[i], bbi = btv[64 + i];
#pragma unroll
    for (int jt = 0; jt < 4; ++jt) {
      const int j0 = jt * 16 + quad * 4;
      f32x4 mf, mb, qf, qb;
#pragma unroll
      for (int jj = 0; jj < 4; ++jj) {
        const int j = j0 + jj;
        const float df = __expf(gfi - gcv[j]);
        const float db = __expf(gbi - gcv[64 + j]);
        mf[jj] = (i > j) ? bfi * kk[jt][jj] * df : 0.f;
        mb[jj] = (i < j) ? bbi * kk[jt][jj] * db : 0.f;
        qf[jj] = (i >= j) ? qk[jt][jj] * df : 0.f;
        qb[jj] = (i <= j) ? qk[jt][jj] * db : 0.f;
      }
      *reinterpret_cast<float4*>(G1 + i * 68 + j0) = make_float4(mf[0], mf[1], mf[2], mf[3]);
      *reinterpret_cast<float4*>(G2 + (63 - i) * 68 + (60 - j0)) = make_float4(mb[3], mb[2], mb[1], mb[0]);
      *reinterpret_cast<uint2*>(p.qkS + dcf * 4096 + (size_t)i * 64 + sigma(j0)) = pack4(qf);
      *reinterpret_cast<uint2*>(p.qkS + dcb * 4096 + (size_t)i * 64 + sigma(j0)) = pack4(qb);
    }
  }
  __syncthreads();
  if (wv < 2) {
    float* G = (wv == 0 ? G1 : G2) + (quad * 16) * 68 + quad * 16;
    float t[16];
#pragma unroll
    for (int i = 0; i < 16; ++i) {
      float a = (i == l16) ? 1.f : 0.f;
#pragma unroll
      for (int j = 0; j < i; ++j) a -= G[i * 68 + j] * t[j];
      t[i] = a;
      asm volatile("" ::: "memory");
    }
#pragma unroll
    for (int i = 0; i < 16; ++i) G[i * 68 + l16] = t[i];
  }
  __syncthreads();
  {
    float* G = ((wv >> 1) ? G2 : G1) + ((wv & 1) * 32) * 68 + (wv & 1) * 32;
    f32x4 x = f32x4{0.f, 0.f, 0.f, 0.f};
#pragma unroll
    for (int st = 0; st < 4; ++st)
      x = __builtin_amdgcn_mfma_f32_16x16x4f32(G[(16 + l16) * 68 + 4 * st + quad], G[(4 * st + quad) * 68 + l16], x, 0, 0, 0);
    f32x4 yv = f32x4{0.f, 0.f, 0.f, 0.f};
#pragma unroll
    for (int j = 0; j < 4; ++j)
      yv = __builtin_amdgcn_mfma_f32_16x16x4f32(G[(16 + l16) * 68 + 16 + 4 * quad + j], x[j], yv, 0, 0, 0);
#pragma unroll
    for (int j = 0; j < 4; ++j) G[(16 + quad * 4 + j) * 68 + l16] = -yv[j];
  }
  __syncthreads();
  {
    float* G = (wv >> 1) ? G2 : G1;
    const int cb = wv & 1;
    f32x4 x0 = f32x4{0.f, 0.f, 0.f, 0.f}, x1 = f32x4{0.f, 0.f, 0.f, 0.f};
#pragma unroll
    for (int st = 0; st < 8; ++st) {
      const float bv = G[(4 * st + quad) * 68 + cb * 16 + l16];
      x0 = __builtin_amdgcn_mfma_f32_16x16x4f32(G[(32 + l16) * 68 + 4 * st + quad], bv, x0, 0, 0, 0);
      x1 = __builtin_amdgcn_mfma_f32_16x16x4f32(G[(48 + l16) * 68 + 4 * st + quad], bv, x1, 0, 0, 0);
    }
    __syncthreads();
    f32x4 y0 = f32x4{0.f, 0.f, 0.f, 0.f}, y1 = f32x4{0.f, 0.f, 0.f, 0.f};
#pragma unroll
    for (int j = 0; j < 4; ++j) {
      y0 = __builtin_amdgcn_mfma_f32_16x16x4f32(G[(32 + l16) * 68 + 32 + 4 * quad + j], x0[j], y0, 0, 0, 0);
      y0 = __builtin_amdgcn_mfma_f32_16x16x4f32(G[(32 + l16) * 68 + 48 + 4 * quad + j], x1[j], y0, 0, 0, 0);
      y1 = __builtin_amdgcn_mfma_f32_16x16x4f32(G[(48 + l16) * 68 + 32 + 4 * quad + j], x0[j], y1, 0, 0, 0);
      y1 = __builtin_amdgcn_mfma_f32_16x16x4f32(G[(48 + l16) * 68 + 48 + 4 * quad + j], x1[j], y1, 0, 0, 0);
    }
#pragma unroll
    for (int j = 0; j < 4; ++j) {
      G[(32 + quad * 4 + j) * 68 + cb * 16 + l16] = -y0[j];
      G[(48 + quad * 4 + j) * 68 + cb * 16 + l16] = -y1[j];
    }
  }
  __syncthreads();
  {
    const int dir = wv >> 1, rh = wv & 1;
    const float* G = dir ? G2 : G1;
    float T[32];
#pragma unroll
    for (int i = 0; i < 32; ++i) T[i] = G[(rh * 32 + i) * 68 + lane];
    __syncthreads();
    const int jcol = dir == 0 ? lane : 63 - lane;
    const float bt = btv[dir * 64 + jcol];
    const float eg = expf(gcv[dir * 64 + jcol]);
    u16* Tu = Tb + (dir * 2 + 0) * (64 * 72);
    u16* Tw = Tb + (dir * 2 + 1) * (64 * 72);
    const int sj = sigma(jcol);
#pragma unroll
    for (int i = 0; i < 32; ++i) {
      const int i0 = rh * 32 + i;
      const int irow = dir == 0 ? i0 : 63 - i0;
      Tu[irow * 72 + sj] = f2bf(T[i] * bt);
      Tw[irow * 72 + sj] = f2bf(T[i] * bt * eg);
    }
  }
  __syncthreads();
  {
    const int dir = wv >> 1, which = wv & 1;
    const u16* Tm = Tb + (dir * 2 + which) * (64 * 72);
    const size_t dc = dir ? dcb : dcf;
    if (which == 0) {
      u16* dst = p.uT + dc * 8192;
#pragma unroll 1
      for (int dt = 0; dt < 8; ++dt) {
        bf16x8 b0 = ld8(vT + (dt * 16 + l16) * 72 + quad * 8);
        bf16x8 b1 = ld8(vT + (dt * 16 + l16) * 72 + 32 + quad * 8);
#pragma unroll
        for (int it = 0; it < 4; ++it) {
          f32x4 a = f32x4{0.f, 0.f, 0.f, 0.f};
          a = mfma16(ld8(Tm + (it * 16 + l16) * 72 + quad * 8), b0, a);
          a = mfma16(ld8(Tm + (it * 16 + l16) * 72 + 32 + quad * 8), b1, a);
          *reinterpret_cast<uint2*>(dst + (size_t)(dt * 16 + l16) * 64 + it * 16 + quad * 4) = pack4(a);
        }
      }
    } else {
      u16* dst = p.wS + dc * 8192;
#pragma unroll 1
      for (int dt = 0; dt < 8; ++dt) {
        bf16x8 a0 = ld8(kT + (dt * 16 + l16) * 72 + quad * 8);
        bf16x8 a1 = ld8(kT + (dt * 16 + l16) * 72 + 32 + quad * 8);
#pragma unroll
        for (int it = 0; it < 4; ++it) {
          f32x4 a = f32x4{0.f, 0.f, 0.f, 0.f};
          a = mfma16(a0, ld8(Tm + (it * 16 + l16) * 72 + quad * 8), a);
          a = mfma16(a1, ld8(Tm + (it * 16 + l16) * 72 + 32 + quad * 8), a);
          *reinterpret_cast<uint2*>(dst + (size_t)(it * 16 + l16) * 128 + sigma(dt * 16 + quad * 4)) = pack4(a);
        }
      }
    }
  }
}

constexpr int SC_WS = 288, SC_KS = 160;
constexpr int SC_W = 0, SC_Q = 64 * SC_WS, SC_K = 2 * 64 * SC_WS, SC_QK = SC_K + 128 * SC_KS, SC_E = SC_QK + 64 * SC_KS, SC_BUF = SC_E + 768;
__device__ void dn_scan_block(const Params& p, const int chain, char* smem, const int tid) {
  const int lane = tid & 63, l16 = lane & 15, quad = lane >> 4, wv = tid >> 6;
  const int dir = chain & 1, bh = chain >> 1;
  __syncthreads();
  if (wv >= 4) {
    const int lt = tid - 256;
    uint4 r0, r1, r2, r3, r4, r5, r6, r7, r8, r9, r10, r11, r12, r13, re;
    float rc;
    const int dwq = (lt >> 4) * SC_WS + (lt & 15) * 16;
    const int dkk = (lt >> 3) * SC_KS + (lt & 7) * 16;
#define SCAN_GLOAD(n_)                                                                                   \
    {                                                                                                    \
      const size_t cidx_ = (size_t)bh * NCH + (n_);                                                      \
      const size_t dc_ = ((size_t)bh * 2 + dir) * NCH + (n_);                                            \
      const uint4* w4 = reinterpret_cast<const uint4*>(p.wS + dc_ * 8192) + lt;                          \
      const uint4* q4 = reinterpret_cast<const uint4*>(p.qn + cidx_ * 8192) + lt;                        \
      const uint4* k4 = reinterpret_cast<const uint4*>(p.knT + cidx_ * 8192) + lt;                       \
      const uint4* g4 = reinterpret_cast<const uint4*>(p.qkS + dc_ * 4096) + lt;                         \
      r0 = w4[0]; r1 = w4[256]; r2 = w4[512]; r3 = w4[768];                                              \
      r4 = q4[0]; r5 = q4[256]; r6 = q4[512]; r7 = q4[768];                                              \
      r8 = k4[0]; r9 = k4[256]; r10 = k4[512]; r11 = k4[768];                                            \
      r12 = g4[0]; r13 = g4[256];                                                                        \
      re = reinterpret_cast<const uint4*>((lt < 16 ? p.egS : p.ekS) + dc_ * 64)[lt & 15];               \
      rc = p.cdS[dc_];                                                                                   \
    }
#define SCAN_SSTORE(buf_)                                                                                \
    {                                                                                                    \
      char* bb_ = smem + (buf_) * SC_BUF;                                                                \
      *reinterpret_cast<uint4*>(bb_ + SC_W + dwq) = r0; *reinterpret_cast<uint4*>(bb_ + SC_W + dwq + 16 * SC_WS) = r1; \
      *reinterpret_cast<uint4*>(bb_ + SC_W + dwq + 32 * SC_WS) = r2; *reinterpret_cast<uint4*>(bb_ + SC_W + dwq + 48 * SC_WS) = r3; \
      *reinterpret_cast<uint4*>(bb_ + SC_Q + dwq) = r4; *reinterpret_cast<uint4*>(bb_ + SC_Q + dwq + 16 * SC_WS) = r5; \
      *reinterpret_cast<uint4*>(bb_ + SC_Q + dwq + 32 * SC_WS) = r6; *reinterpret_cast<uint4*>(bb_ + SC_Q + dwq + 48 * SC_WS) = r7; \
      *reinterpret_cast<uint4*>(bb_ + SC_K + dkk) = r8; *reinterpret_cast<uint4*>(bb_ + SC_K + dkk + 32 * SC_KS) = r9; \
      *reinterpret_cast<uint4*>(bb_ + SC_K + dkk + 64 * SC_KS) = r10; *reinterpret_cast<uint4*>(bb_ + SC_K + dkk + 96 * SC_KS) = r11; \
      *reinterpret_cast<uint4*>(bb_ + SC_QK + dkk) = r12; *reinterpret_cast<uint4*>(bb_ + SC_QK + dkk + 32 * SC_KS) = r13; \
      if (lt < 32) *reinterpret_cast<uint4*>(bb_ + SC_E + lt * 16) = re;                                  \
      if (lt == 32) *reinterpret_cast<float*>(bb_ + SC_E + 512) = rc;                                     \
    }
    SCAN_GLOAD(dir ? (NCH - 1) : 0);
    SCAN_SSTORE(0);
    SCAN_GLOAD(dir ? (NCH - 2) : 1);
    __syncthreads();
#pragma unroll 1
    for (int step = 0; step < NCH; ++step) {
      if (step + 1 < NCH) {
        SCAN_SSTORE((step + 1) & 1);
        const int s2 = min(step + 2, NCH - 1);
        SCAN_GLOAD(dir ? (NCH - 1 - s2) : s2);
      }
      __syncthreads();
    }
#undef SCAN_GLOAD
#undef SCAN_SSTORE
  } else {
    __builtin_amdgcn_s_setprio(3);
    f32x4 S0[8], S1[8];
#pragma unroll
    for (int k = 0; k < 8; ++k) { S0[k] = f32x4{0.f, 0.f, 0.f, 0.f}; S1[k] = f32x4{0.f, 0.f, 0.f, 0.f}; }
    uint2 un00, un01, un02, un03, un10, un11, un12, un13;
#define SCAN_ULOAD(n_)                                                                                   \
    {                                                                                                    \
      const size_t dc_ = ((size_t)bh * 2 + dir) * NCH + (n_);                                            \
      const u16* up_ = p.uT + dc_ * 8192 + (size_t)(wv * 32 + l16) * 64 + quad * 4;                      \
      un00 = *reinterpret_cast<const uint2*>(up_); un01 = *reinterpret_cast<const uint2*>(up_ + 16);     \
      un02 = *reinterpret_cast<const uint2*>(up_ + 32); un03 = *reinterpret_cast<const uint2*>(up_ + 48); \
      un10 = *reinterpret_cast<const uint2*>(up_ + 1024); un11 = *reinterpret_cast<const uint2*>(up_ + 1040); \
      un12 = *reinterpret_cast<const uint2*>(up_ + 1056); un13 = *reinterpret_cast<const uint2*>(up_ + 1072); \
    }
    SCAN_ULOAD(dir ? (NCH - 1) : 0);
    __syncthreads();
#pragma unroll 1
    for (int step = 0; step < NCH; ++step) {
      const int n = dir ? (NCH - 1 - step) : step;
      const size_t dc = ((size_t)bh * 2 + dir) * NCH + n;
      const uint2 uc00 = un00, uc01 = un01, uc02 = un02, uc03 = un03, uc10 = un10, uc11 = un11, uc12 = un12, uc13 = un13;
      {
        const int s1 = min(step + 1, NCH - 1);
        SCAN_ULOAD(dir ? (NCH - 1 - s1) : s1);
      }
      const char* bb = smem + (step & 1) * SC_BUF;
      const u16* wp = reinterpret_cast<const u16*>(bb + SC_W);
      const u16* qp = reinterpret_cast<const u16*>(bb + SC_Q);
      const u16* kp = reinterpret_cast<const u16*>(bb + SC_K);
      const u16* qkp = reinterpret_cast<const u16*>(bb + SC_QK);
      const float* egp = reinterpret_cast<const float*>(bb + SC_E);
      const float* ekp = egp + 64;
      const float cd = egp[128];
      u16* up = p.uT + dc * 8192 + (size_t)(wv * 32 + l16) * 64;
      bf16x8 Sb0[4], Sb1[4];
#pragma unroll
      for (int ks = 0; ks < 4; ++ks) { Sb0[ks] = pack8(S0[2 * ks], S0[2 * ks + 1]); Sb1[ks] = pack8(S1[2 * ks], S1[2 * ks + 1]); }
      f32x4 vn0[4], vn1[4], oa0[4], oa1[4];
#pragma unroll
      for (int ct = 0; ct < 4; ++ct) {
        f32x4 a0 = f32x4{0.f, 0.f, 0.f, 0.f}, a1 = a0;
#pragma unroll
        for (int ks = 0; ks < 4; ++ks) {
          const bf16x8 wf = ld8(wp + (ct * 16 + l16) * (SC_WS / 2) + ks * 32 + quad * 8);
          a0 = mfma16(wf, Sb0[ks], a0); a1 = mfma16(wf, Sb1[ks], a1);
        }
        const uint2 u0 = (ct == 0) ? uc00 : (ct == 1) ? uc01 : (ct == 2) ? uc02 : uc03;
        const uint2 u1 = (ct == 0) ? uc10 : (ct == 1) ? uc11 : (ct == 2) ? uc12 : uc13;
        vn0[ct][0] = bf2f((u16)(u0.x & 0xffff)) - a0[0]; vn0[ct][1] = bf2f((u16)(u0.x >> 16)) - a0[1];
        vn0[ct][2] = bf2f((u16)(u0.y & 0xffff)) - a0[2]; vn0[ct][3] = bf2f((u16)(u0.y >> 16)) - a0[3];
        vn1[ct][0] = bf2f((u16)(u1.x & 0xffff)) - a1[0]; vn1[ct][1] = bf2f((u16)(u1.x >> 16)) - a1[1];
        vn1[ct][2] = bf2f((u16)(u1.y & 0xffff)) - a1[2]; vn1[ct][3] = bf2f((u16)(u1.y >> 16)) - a1[3];
      }
#pragma unroll
      for (int ct = 0; ct < 4; ++ct) {
        f32x4 o0 = f32x4{0.f, 0.f, 0.f, 0.f}, o1 = o0;
#pragma unroll
        for (int ks = 0; ks < 4; ++ks) {
          const bf16x8 qf = ld8(qp + (ct * 16 + l16) * (SC_WS / 2) + ks * 32 + quad * 8);
          o0 = mfma16(qf, Sb0[ks], o0); o1 = mfma16(qf, Sb1[ks], o1);
        }
        const float4 eg = *reinterpret_cast<const float4*>(egp + ct * 16 + quad * 4);
        oa0[ct][0] = o0[0] * eg.x; oa0[ct][1] = o0[1] * eg.y; oa0[ct][2] = o0[2] * eg.z; oa0[ct][3] = o0[3] * eg.w;
        oa1[ct][0] = o1[0] * eg.x; oa1[ct][1] = o1[1] * eg.y; oa1[ct][2] = o1[2] * eg.z; oa1[ct][3] = o1[3] * eg.w;
      }
      bf16x8 Vb0[2], Vb1[2], Eb0[2], Eb1[2];
#pragma unroll
      for (int k2 = 0; k2 < 2; ++k2) {
        Vb0[k2] = pack8(vn0[2 * k2], vn0[2 * k2 + 1]);
        Vb1[k2] = pack8(vn1[2 * k2], vn1[2 * k2 + 1]);
        const float4 e0 = *reinterpret_cast<const float4*>(ekp + (2 * k2) * 16 + quad * 4);
        const float4 e1 = *reinterpret_cast<const float4*>(ekp + (2 * k2 + 1) * 16 + quad * 4);
        f32x4 x0 = vn0[2 * k2], x1 = vn0[2 * k2 + 1], y0 = vn1[2 * k2], y1 = vn1[2 * k2 + 1];
        x0[0] *= e0.x; x0[1] *= e0.y; x0[2] *= e0.z; x0[3] *= e0.w;
        x1[0] *= e1.x; x1[1] *= e1.y; x1[2] *= e1.z; x1[3] *= e1.w;
        y0[0] *= e0.x; y0[1] *= e0.y; y0[2] *= e0.z; y0[3] *= e0.w;
        y1[0] *= e1.x; y1[1] *= e1.y; y1[2] *= e1.z; y1[3] *= e1.w;
        Eb0[k2] = pack8(x0, x1);
        Eb1[k2] = pack8(y0, y1);
      }
#pragma unroll
      for (int ct = 0; ct < 4; ++ct) {
        f32x4 o0 = oa0[ct], o1 = oa1[ct];
#pragma unroll
        for (int k2 = 0; k2 < 2; ++k2) {
          const bf16x8 gf = ld8(qkp + (ct * 16 + l16) * (SC_KS / 2) + k2 * 32 + quad * 8);
          o0 = mfma16(gf, Vb0[k2], o0); o1 = mfma16(gf, Vb1[k2], o1);
        }
        *reinterpret_cast<uint2*>(up + ct * 16 + quad * 4) = pack4(o0);
        *reinterpret_cast<uint2*>(up + 1024 + ct * 16 + quad * 4) = pack4(o1);
      }
#pragma unroll
      for (int kt = 0; kt < 8; ++kt) {
        f32x4 s0 = S0[kt] * cd, s1 = S1[kt] * cd;
#pragma unroll
        for (int k2 = 0; k2 < 2; ++k2) {
          const bf16x8 kf = ld8(kp + (kt * 16 + l16) * (SC_KS / 2) + k2 * 32 + quad * 8);
          s0 = mfma16(kf, Eb0[k2], s0); s1 = mfma16(kf, Eb1[k2], s1);
        }
        S0[kt] = s0; S1[kt] = s1;
      }
      __syncthreads();
    }
    __builtin_amdgcn_s_setprio(0);
#undef SCAN_ULOAD
  }
}

__device__ void dn_combine(const Params& p, int item, char* smem, const int tid) {
  const int h = item & 3, n = (item >> 2) % NCH, b = item / (4 * NCH);
  float* sl = (float*)smem;
  const size_t dcf = ((size_t)(b * 4 + h) * 2 + 0) * NCH + n;
  const size_t dcb = ((size_t)(b * 4 + h) * 2 + 1) * NCH + n;
  const int c = tid >> 2, part = tid & 3;
  const int t = n * 64 - 48 + c;
  const size_t mrow = (size_t)b * LL + (t >= 0 ? t : 0);
  u16* dp = p.proj + mrow * PW + PC_Z + h * 128 + part * 32;
  const bf16x8 z0 = ld8(dp), z1 = ld8(dp + 8), z2 = ld8(dp + 16), z3 = ld8(dp + 24);
  __syncthreads();
#pragma unroll
  for (int i = 0; i < 4; ++i) {
    const int e8 = tid + i * 256;
    const int v = e8 >> 3, c0 = (e8 & 7) * 8;
    bf16x8 a = ld8(p.uT + dcf * 8192 + (size_t)e8 * 8);
    bf16x8 bb = ld8(p.uT + dcb * 8192 + (size_t)e8 * 8);
#pragma unroll
    for (int e = 0; e < 8; ++e) sl[v * 65 + (v >> 5) * 8 + c0 + e] = bf2f((u16)a[e]) + bf2f((u16)bb[e]);
  }
  __syncthreads();
  float vals[32];
  float ss = 0.f;
#pragma unroll
  for (int e = 0; e < 32; ++e) { float v = sl[(part * 32 + e) * 65 + part * 8 + c]; vals[e] = v; ss += v * v; }
  ss += __shfl_xor(ss, 1); ss += __shfl_xor(ss, 2);
  const float rs = rsqrtf(ss * (1.f / 128.f) + EPSF);
  if (t >= 0) {
#pragma unroll
    for (int e8 = 0; e8 < 4; ++e8) {
      const bf16x8 z = (e8 == 0) ? z0 : (e8 == 1) ? z1 : (e8 == 2) ? z2 : z3;
      float r[8];
#pragma unroll
      for (int e = 0; e < 8; ++e) {
        float zz = bf2f((u16)z[e]);
        r[e] = vals[e8 * 8 + e] * rs * p.norm_g[part * 32 + e8 * 8 + e] * (zz * __builtin_amdgcn_rcpf(1.f + __expf(-zz)));
      }
      *reinterpret_cast<uint4*>(dp + e8 * 8) = make_uint4(pack2(r[0], r[1]), pack2(r[2], r[3]), pack2(r[4], r[5]), pack2(r[6], r[7]));
    }
  }
}

__device__ void final_norm(const Params& p) {
  const int lane = threadIdx.x & 63;
  const int gw = blockIdx.x * (NTHR / 64) + (threadIdx.x >> 6), nw = gridDim.x * (NTHR / 64);
  float4 g[2][2];
#pragma unroll
  for (int q = 0; q < 2; ++q) {
    g[q][0] = *reinterpret_cast<const float4*>(p.g_final + q * 512 + lane * 8);
    g[q][1] = *reinterpret_cast<const float4*>(p.g_final + q * 512 + lane * 8 + 4);
  }
  for (int row = gw * 4; row < MC; row += nw * 4) {
    uint4 v[4][2];
    float rs[4];
#pragma unroll
    for (int r = 0; r < 4; ++r) {
      const u16* src = p.h2b + (size_t)(row + r) * DM + lane * 8;
      v[r][0] = *reinterpret_cast<const uint4*>(src); v[r][1] = *reinterpret_cast<const uint4*>(src + 512);
      rs[r] = p.ss3[row + r];
    }
#pragma unroll
    for (int r = 0; r < 4; ++r) {
      const float sc = rsqrtf(rs[r] * (1.f / DM) + EPSF);
      float* dst = p.out + (size_t)(row + r) * DM + lane * 8;
#pragma unroll
      for (int q = 0; q < 2; ++q) {
        const uint4 w = v[r][q];
        const float4 a = make_float4(__uint_as_float(w.x << 16) * sc * g[q][0].x, __uint_as_float(w.x & 0xffff0000u) * sc * g[q][0].y,
                                     __uint_as_float(w.y << 16) * sc * g[q][0].z, __uint_as_float(w.y & 0xffff0000u) * sc * g[q][0].w);
        const float4 c = make_float4(__uint_as_float(w.z << 16) * sc * g[q][1].x, __uint_as_float(w.z & 0xffff0000u) * sc * g[q][1].y,
                                     __uint_as_float(w.w << 16) * sc * g[q][1].z, __uint_as_float(w.w & 0xffff0000u) * sc * g[q][1].w);
        *reinterpret_cast<float4*>(dst + q * 512) = a;
        *reinterpret_cast<float4*>(dst + q * 512 + 4) = c;
      }
    }
  }
}

#define XB_TMO      128
#define XB_XCNT(j)  (256  + 64 * (j))
#define XB_XSUB(j)  (1280 + 64 * (j))
#define XB_XGEN(j)  (2304 + 64 * (j))
#define XB_TOP      3328
#define XB_TOPGEN   3392
#define XCD_BAR_WORDS 3456
#define XB_SPIN_CAP (1u << 18)
__device__ __forceinline__ unsigned xb_ld(unsigned* p)              { return __hip_atomic_load(p, __ATOMIC_RELAXED, __HIP_MEMORY_SCOPE_AGENT); }
__device__ __forceinline__ unsigned xb_add(unsigned* p, unsigned v) { return __hip_atomic_fetch_add(p, v, __ATOMIC_RELAXED, __HIP_MEMORY_SCOPE_AGENT); }
__device__ __forceinline__ unsigned xb_xcc_id() { return (unsigned)__builtin_amdgcn_s_getreg((3 << 11) | 20) & 0xFu; }
#define XB_SPIN(cond, bar) do { unsigned _sp = 0; while (cond) { __builtin_amdgcn_s_sleep(1); \
    if ((++_sp & 255u) == 0u) { if (xb_ld(&(bar)[XB_TMO])) break; if (_sp > XB_SPIN_CAP) { atomicAdd(&(bar)[XB_TMO], 1u); break; } } } } while (0)
struct XcdBarrier { unsigned* bar; unsigned x; volatile LAS unsigned* st; };
__device__ __forceinline__ XcdBarrier xcd_barrier_post(unsigned* bar, volatile LAS unsigned* st) {
  XcdBarrier b; b.bar = bar; b.x = xb_xcc_id(); b.st = st;
  if (threadIdx.x == 0) (void)xb_add(&bar[XB_XCNT(b.x)], 1u);
  return b;
}
__device__ __forceinline__ void xcd_barrier_complete(unsigned* bar, unsigned x, unsigned& nloc, unsigned& nx) {
  const unsigned G = gridDim.x * gridDim.y * gridDim.z;
  unsigned sum, cnt, mine, sp = 0u;
  for (;;) {
    sum = 0u; cnt = 0u; mine = 0u;
#pragma unroll
    for (unsigned j = 0; j < 16; ++j) { const unsigned c = xb_ld(&bar[XB_XCNT(j)]); sum += c; cnt += (c > 0u) ? 1u : 0u; mine = (j == x) ? c : mine; }
    if (sum == G) break;
    __builtin_amdgcn_s_sleep(1);
    if ((++sp & 255u) == 0u) { if (xb_ld(&bar[XB_TMO])) break; if (sp > XB_SPIN_CAP) { atomicAdd(&bar[XB_TMO], 1u); break; } }
  }
  nloc = mine > 0u ? mine : 1u; nx = cnt > 0u ? cnt : 1u;
}
__device__ __forceinline__ void xcd_barrier(const XcdBarrier& b) {
  asm volatile("s_waitcnt vmcnt(0)" ::: "memory");
  __syncthreads();
  if (threadIdx.x == 0) {
    unsigned* bar = b.bar;
    __builtin_amdgcn_s_waitcnt(0);
    unsigned nloc = b.st[0], nx = b.st[1];
    if (nloc == 0u) { xcd_barrier_complete(bar, b.x, nloc, nx); b.st[0] = nloc; b.st[1] = nx; }
    const unsigned old = xb_add(&bar[XB_XSUB(b.x)], 1u);
    const unsigned gen = old / nloc;
    if (old + 1u == (gen + 1u) * nloc) {
      __builtin_amdgcn_fence(__ATOMIC_RELEASE, "agent");
      asm volatile("s_waitcnt vmcnt(0)" ::: "memory");
      const unsigned og = xb_add(&bar[XB_TOP], 1u);
      const unsigned tg = og / nx;
      if (og + 1u == (tg + 1u) * nx) xb_add(&bar[XB_TOPGEN], 1u);
      else XB_SPIN(xb_ld(&bar[XB_TOPGEN]) == tg, bar);
      __builtin_amdgcn_fence(__ATOMIC_ACQUIRE, "agent");
      xb_add(&bar[XB_XGEN(b.x)], 1u);
      asm volatile("s_waitcnt vmcnt(0)" ::: "memory");
    } else {
      XB_SPIN(xb_ld(&bar[XB_XGEN(b.x)]) == gen, bar);
      __builtin_amdgcn_fence(__ATOMIC_ACQUIRE, "agent");
      asm volatile("s_waitcnt vmcnt(0)" ::: "memory");
    }
  }
  __syncthreads();
}

__global__ void __launch_bounds__(NTHR, 2) mega(Params p) {
  extern __shared__ __attribute__((aligned(16))) char smem[];
  cg::grid_group grid = cg::this_grid();
  volatile LAS unsigned* xbst = (volatile LAS unsigned*)(smem + LDS_BYTES);
  if (threadIdx.x == 0) { xbst[0] = 0u; xbst[1] = 0u; xbst[2] = 0u; xbst[3] = 0u; }
  __syncthreads();
  XcdBarrier xb; xb.bar = p.bar; xb.x = xb_xcc_id(); xb.st = xbst;
  if (blockIdx.x == 0) for (int i = threadIdx.x; i < XCD_BAR_WORDS; i += NTHR) p.bar[i] = 0u;
  const int lo = p.phase_lo, hi = p.phase_hi;
#define PH_BEGIN(n) if (lo <= (n) && (n) < hi) { if ((n) > lo) { if ((n) == 1) { grid.sync(); if (threadIdx.x == 0) (void)xb_add(&p.bar[XB_XCNT(xb.x)], 1u); } else xcd_barrier(xb); } int otid_ = threadIdx.x; asm volatile("" : "+v"(otid_)); const int half = otid_ >> 8, tid2 = otid_ & 255; char* hsm = smem + half * HLDS; (void)tid2; (void)hsm;
#define PH_END }
  PH_BEGIN(0) phase0(p, smem); PH_END
  PH_BEGIN(1) { gemm_phase<1, false>(p, (LAS unsigned char*)smem, p.hb, DM, p.WinT, INP / BM, DM); meta_inproj(p); } PH_END
  PH_BEGIN(2) {
    const int NDN = NB * NCH * 4;
    for (int it = blockIdx.x * 2 + half; it < NDN; it += gridDim.x * 2) dn_prep(p, it, hsm, tid2);
  } PH_END
  PH_BEGIN(3) {
    const bool split = gridDim.x > 64;
    const int nsc = split ? 64 : (int)gridDim.x;
    if ((int)blockIdx.x < nsc)
      for (int ch = blockIdx.x; ch < 64; ch += nsc) dn_scan_block(p, ch, smem, otid_);
    const int nb = split ? (int)blockIdx.x - 64 : (int)blockIdx.x;
    if (nb >= 0) na_items(p, hsm, tid2, nb * 2 + half, (split ? (int)gridDim.x - 64 : (int)gridDim.x) * 2);
  } PH_END
  PH_BEGIN(4) {
    for (int it = blockIdx.x * 2 + half; it < NB * NCH * 4; it += gridDim.x * 2) dn_combine(p, it, hsm, tid2);
  } PH_END
  PH_BEGIN(5) gemm_phase<3, true>(p, (LAS unsigned char*)smem, p.proj, PW, p.WoutT, DM / BM, DM); PH_END
  PH_BEGIN(6) gemm_phase<4, false>(p, (LAS unsigned char*)smem, p.h1b, DM, p.WguT, (2 * DFF) / BM, DM); PH_END
  PH_BEGIN(7) gemm_phase<5, false>(p, (LAS unsigned char*)smem, p.act, DFF, p.WdT, DM / BM, DFF); PH_END
  PH_BEGIN(8) final_norm(p); PH_END
}

static inline size_t al256(size_t v) { return (v + 255) & ~(size_t)255; }

extern "C" void kernel_launch(void* const* d_in, const int* in_sizes, int n_in, void* d_out, int out_size, void* d_ws, size_t ws_size,
                              hipStream_t stream) {
  static int grid_blocks = 0;
  if (!grid_blocks) {
    int dev = 0, cus = 0, per_cu = 0;
    hipGetDevice(&dev);
    hipDeviceGetAttribute(&cus, hipDeviceAttributeMultiprocessorCount, dev);
    hipFuncSetAttribute((const void*)mega, hipFuncAttributeMaxDynamicSharedMemorySize, LDS_BYTES + 16);
    hipOccupancyMaxActiveBlocksPerMultiprocessor(&per_cu, (const void*)mega, NTHR, LDS_BYTES + 16);
    if (per_cu < 1) per_cu = 1;
    if (per_cu > 1) per_cu = 1;
    grid_blocks = cus * per_cu;
    grid_blocks &= ~7;
    fprintf(stderr, "mega: cus %d per_cu %d grid %d ws %zu\n", cus, per_cu, grid_blocks, ws_size);
  }
  Params p{};
  p.x = (const float*)d_in[0]; p.meta = (const float*)d_in[1]; p.g_mix = (const float*)d_in[2]; p.w_in = (const float*)d_in[3];
  p.rel_bias = (const float*)d_in[4]; p.conv_w = (const float*)d_in[5]; p.a_log = (const float*)d_in[6]; p.dt_bias = (const float*)d_in[7];
  p.norm_g = (const float*)d_in[8]; p.w_out = (const float*)d_in[9]; p.g_ffn = (const float*)d_in[10]; p.w_gate = (const float*)d_in[11];
  p.w_up = (const float*)d_in[12]; p.w_down = (const float*)d_in[13]; p.g_final = (const float*)d_in[14];
  p.out = (float*)d_out;
  char* ws = (char*)d_ws;
  size_t off = 0;
  auto take = [&](size_t bytes) { char* r = ws + off; off += al256(bytes); return r; };
  p.WinT = (u16*)take((size_t)INP * DM * 2);
  p.WoutT = (u16*)take((size_t)DM * DM * 2);
  p.WguT = (u16*)take((size_t)2 * DFF * DM * 2);
  p.WdT = (u16*)take((size_t)DM * DFF * 2);
  p.bar = (unsigned*)take((size_t)XCD_BAR_WORDS * 4);
  p.rs1 = (float*)take((size_t)MT * 4);
  p.ss2 = (float*)take((size_t)MT * 4);
  p.ss3 = (float*)take((size_t)MT * 4);
  char* preg = take((size_t)MT * PW * 2);
  p.proj = (u16*)preg;
  p.act = (u16*)preg;
  p.Vt = (u16*)take((size_t)NB * 512 * LL * 2);
  char* xreg = ws + off;
  p.hb = (u16*)xreg;
  {
    size_t o2 = 0;
    auto tk = [&](size_t bytes) { char* r = xreg + o2; o2 += al256(bytes); return r; };
    const size_t NCK = (size_t)NB * 4 * NCH;
    p.qn = (u16*)tk(NCK * 8192 * 2);
    p.knT = (u16*)tk(NCK * 8192 * 2);
    p.uT = (u16*)tk(2 * NCK * 8192 * 2);
    p.wS = (u16*)tk(2 * NCK * 8192 * 2);
    p.qkS = (u16*)tk(2 * NCK * 4096 * 2);
    p.egS = (float*)tk(2 * NCK * 64 * 4);
    p.ekS = (float*)tk(2 * NCK * 64 * 4);
    p.cdS = (float*)tk(2 * NCK * 4);
    if (off + o2 > ws_size) fprintf(stderr, "mega: workspace too small: need %zu have %zu\n", off + o2, ws_size);
  }
  p.h1 = (float*)xreg;
  p.h2b = (u16*)xreg;
  p.h1b = (u16*)(xreg + al256((size_t)MC * DM * 4));
  p.phase_lo = 0; p.phase_hi = 9;
  void* args[] = {&p};
  hipError_t e = hipLaunchCooperativeKernel((const void*)mega, dim3(grid_blocks), dim3(NTHR), args, LDS_BYTES + 16, stream);
  if (e != hipSuccess) fprintf(stderr, "cooperative launch failed: %s (grid %d)\n", hipGetErrorString(e), grid_blocks);
}
```
